# Optimizing an MI355X kernel written in HIP

```python
import jax, jax.numpy as jnp
from jax import lax
import numpy as np

D_MODEL = 2048
BATCH = 4
SEQ = 8192
DEPTH = 1
DEC_BATCH = 16
DEC_SEQ = 32
PAST_LEN = 1024

CHUNK = 64
HEAD_DIM = 128
FOX_WIDTH = D_MODEL // 2
N_FOX_HEADS = FOX_WIDTH // HEAD_DIM
POOL_WIDTH = D_MODEL - FOX_WIDTH
POOL_WINDOWS = (2, 4, 8, 16)
N_POOL_GROUPS = len(POOL_WINDOWS)
POOL_GROUP_DIM = POOL_WIDTH // N_POOL_GROUPS
POOL_HIST = max(POOL_WINDOWS) - 1
MIX_WIDTH = FOX_WIDTH + POOL_WIDTH
IN_WIDTH = 3 * FOX_WIDTH + N_FOX_HEADS + POOL_WIDTH
D_FF = 256 * ((8 * D_MODEL + 3 * 256 - 1) // (3 * 256))
Q_BLOCK = 128
EPS = 1e-6
ATTN_SCALE = HEAD_DIM ** -0.5

kernel_name = 'fox_pool_macaron_stream_step'


def _rms_norm(x, g):
    xf = x.astype(jnp.float32)
    y = xf * lax.rsqrt(jnp.mean(xf * xf, axis=-1, keepdims=True) + EPS)
    return (y * g.astype(jnp.float32)).astype(x.dtype)


def _swiglu(x, w_gate, w_up, w_down):
    return (jax.nn.silu(x @ w_gate) * (x @ w_up)) @ w_down


def _split_groups(u, b_f):
    B, T, _ = u.shape
    hs = (B, T, N_FOX_HEADS, HEAD_DIM)
    q = u[..., :FOX_WIDTH].reshape(hs)
    k = u[..., FOX_WIDTH:2 * FOX_WIDTH].reshape(hs)
    v = u[..., 2 * FOX_WIDTH:3 * FOX_WIDTH].reshape(hs)
    o = 3 * FOX_WIDTH
    logf = jax.nn.log_sigmoid(u[..., o:o + N_FOX_HEADS].astype(jnp.float32) + b_f.astype(jnp.float32))
    p = u[..., o + N_FOX_HEADS:]
    return q, k, v, logf, p


def _fox_block(q, k, v, c_q, c_k, q_pos, k_pos):
    s = jnp.einsum('bqhd,bkhd->bhqk', q, k).astype(jnp.float32) * ATTN_SCALE
    s = s + c_q[..., :, None] - c_k[:, :, None, :]
    s = jnp.where(k_pos[None, :] <= q_pos[:, None], s, -jnp.inf)
    p = jax.nn.softmax(s, axis=-1).astype(v.dtype)
    return jnp.einsum('bhqk,bkhd->bqhd', p, v)


def _fox_prompt(q, k, v, logf):
    B, S, H, Dh = q.shape
    nb = S // Q_BLOCK
    c = jnp.cumsum(logf, axis=1).transpose(0, 2, 1)
    qb = q.reshape(B, nb, Q_BLOCK, H, Dh).swapaxes(0, 1)
    cqb = c.reshape(B, H, nb, Q_BLOCK).transpose(2, 0, 1, 3)
    pos = jnp.arange(S, dtype=jnp.int32)
    qposb = pos.reshape(nb, Q_BLOCK)
    out = lax.map(lambda blk: _fox_block(blk[0], k, v, blk[1], c, blk[2], pos), (qb, cqb, qposb))
    return out.swapaxes(0, 1).reshape(B, S, H * Dh)


def _fox_sample(q, k, v, logf, cache_k, cache_v, cache_logf):
    B, T, H, Dh = q.shape
    P = cache_k.shape[1]
    k_all = jnp.concatenate([cache_k.astype(k.dtype), k], axis=1)
    v_all = jnp.concatenate([cache_v.astype(v.dtype), v], axis=1)
    lf_all = jnp.concatenate([cache_logf.astype(jnp.float32), logf], axis=1)
    c = jnp.cumsum(lf_all, axis=1).transpose(0, 2, 1)
    k_pos = jnp.arange(P + T, dtype=jnp.int32)
    q_pos = P + jnp.arange(T, dtype=jnp.int32)
    out = _fox_block(q, k_all, v_all, c[:, :, P:], c, q_pos, k_pos)
    return out.reshape(B, T, H * Dh)


def _pool_mix(ext, pos_out, w_pool, pool_scale):
    L = ext.shape[1]
    n = pos_out.shape[0]
    start = L - n
    xf = ext.astype(jnp.float32)
    cs = jnp.cumsum(xf, axis=1)
    cs0 = jnp.concatenate([jnp.zeros_like(cs[:, :1]), cs], axis=1)
    outs = []
    for g, w in enumerate(POOL_WINDOWS):
        sl = slice(g * POOL_GROUP_DIM, (g + 1) * POOL_GROUP_DIM)
        tot = cs0[:, start + 1:L + 1, sl] - cs0[:, start + 1 - w:L + 1 - w, sl]
        cnt = jnp.minimum(pos_out + 1, w).astype(jnp.float32)[None, :, None]
        d = (tot / cnt - xf[:, start:, sl]).astype(ext.dtype)
        outs.append(d @ w_pool[g])
    return jnp.concatenate(outs, axis=-1) * pool_scale


def _pre_mix(x, g_ffn1, w1_gate, w1_up, w1_down, g_mix, w_in, b_f):
    h = x + 0.5 * _swiglu(_rms_norm(x, g_ffn1), w1_gate, w1_up, w1_down)
    u = _rms_norm(h, g_mix) @ w_in
    q, k, v, logf, p = _split_groups(u, b_f)
    return h, q, k, v, logf, p


def _post_mix(h, fox_out, pool_out, w_o, g_ffn2, w2_gate, w2_up, w2_down):
    h = h + jnp.concatenate([fox_out, pool_out.astype(fox_out.dtype)], axis=-1) @ w_o
    return h + 0.5 * _swiglu(_rms_norm(h, g_ffn2), w2_gate, w2_up, w2_down)


def setup_inputs(seed: int = 0) -> dict:
    key = jax.random.key(seed)
    ks = jax.random.split(key, 24)

    def nrm(k, shape, scale=1.0):
        return jax.random.normal(k, shape, jnp.float32) * scale

    Ld = DEPTH
    inp = {}
    inp['x_prompt'] = nrm(ks[0], (BATCH, SEQ, D_MODEL))
    inp['x_sample'] = nrm(ks[1], (DEC_BATCH, DEC_SEQ, D_MODEL))
    inp['cache_k'] = nrm(ks[2], (Ld, DEC_BATCH, PAST_LEN, N_FOX_HEADS, HEAD_DIM))
    inp['cache_v'] = nrm(ks[3], (Ld, DEC_BATCH, PAST_LEN, N_FOX_HEADS, HEAD_DIM))
    inp['cache_logf'] = jax.nn.log_sigmoid(
        jax.random.uniform(ks[4], (Ld, DEC_BATCH, PAST_LEN, N_FOX_HEADS), jnp.float32, 1.0, 5.0)
        + nrm(ks[5], (Ld, DEC_BATCH, PAST_LEN, N_FOX_HEADS), 0.5))
    inp['state_pool'] = nrm(ks[6], (Ld, DEC_BATCH, POOL_HIST, POOL_WIDTH))
    inp['g_ffn1'] = 1.0 + nrm(ks[7], (Ld, D_MODEL), 0.02)
    inp['w1_gate'] = nrm(ks[8], (Ld, D_MODEL, D_FF), D_MODEL ** -0.5)
    inp['w1_up'] = nrm(ks[9], (Ld, D_MODEL, D_FF), D_MODEL ** -0.5)
    inp['w1_down'] = nrm(ks[10], (Ld, D_FF, D_MODEL), D_FF ** -0.5)
    inp['g_mix'] = 1.0 + nrm(ks[11], (Ld, D_MODEL), 0.02)
    inp['w_in'] = nrm(ks[12], (Ld, D_MODEL, IN_WIDTH), D_MODEL ** -0.5)
    inp['b_f'] = jax.random.uniform(ks[13], (Ld, N_FOX_HEADS), jnp.float32, 1.0, 5.0)
    inp['w_pool'] = nrm(ks[14], (Ld, N_POOL_GROUPS, POOL_GROUP_DIM, POOL_GROUP_DIM), POOL_GROUP_DIM ** -0.5)
    inp['pool_scale'] = 1.0 + nrm(ks[15], (Ld, POOL_WIDTH), 0.1)
    inp['w_o'] = nrm(ks[16], (Ld, MIX_WIDTH, D_MODEL), MIX_WIDTH ** -0.5)
    inp['g_ffn2'] = 1.0 + nrm(ks[17], (Ld, D_MODEL), 0.02)
    inp['w2_gate'] = nrm(ks[18], (Ld, D_MODEL, D_FF), D_MODEL ** -0.5)
    inp['w2_up'] = nrm(ks[19], (Ld, D_MODEL, D_FF), D_MODEL ** -0.5)
    inp['w2_down'] = nrm(ks[20], (Ld, D_FF, D_MODEL), D_FF ** -0.5)
    inp['g_final'] = 1.0 + nrm(ks[21], (D_MODEL,), 0.02)
    return inp


def reference(x_prompt, x_sample, cache_k, cache_v, cache_logf, state_pool,
              g_ffn1, w1_gate, w1_up, w1_down, g_mix, w_in, b_f, w_pool, pool_scale,
              w_o, g_ffn2, w2_gate, w2_up, w2_down, g_final):
    B, S, _ = x_prompt.shape
    Tn = x_sample.shape[1]
    P = cache_k.shape[2]
    pos_prompt = jnp.arange(S, dtype=jnp.int32)
    pos_sample = P + jnp.arange(Tn, dtype=jnp.int32)

    hp, hs = x_prompt, x_sample
    kp_l, vp_l, lfp_l, pp_l = [], [], [], []
    ks_l, vs_l, lfs_l, ps_l = [], [], [], []
    for l in range(DEPTH):
        h, q, k, v, logf, p = _pre_mix(hp, g_ffn1[l], w1_gate[l], w1_up[l], w1_down[l], g_mix[l], w_in[l], b_f[l])
        fox_out = _fox_prompt(q, k, v, logf)
        ext = jnp.concatenate([jnp.zeros((B, POOL_HIST, POOL_WIDTH), p.dtype), p], axis=1)
        pool_out = _pool_mix(ext, pos_prompt, w_pool[l], pool_scale[l])
        hp = _post_mix(h, fox_out, pool_out, w_o[l], g_ffn2[l], w2_gate[l], w2_up[l], w2_down[l])
        kp_l.append(k); vp_l.append(v); lfp_l.append(logf); pp_l.append(ext[:, -POOL_HIST:])

        h, q, k, v, logf, p = _pre_mix(hs, g_ffn1[l], w1_gate[l], w1_up[l], w1_down[l], g_mix[l], w_in[l], b_f[l])
        fox_out = _fox_sample(q, k, v, logf, cache_k[l], cache_v[l], cache_logf[l])
        ext = jnp.concatenate([state_pool[l].astype(p.dtype), p], axis=1)
        pool_out = _pool_mix(ext, pos_sample, w_pool[l], pool_scale[l])
        hs = _post_mix(h, fox_out, pool_out, w_o[l], g_ffn2[l], w2_gate[l], w2_up[l], w2_down[l])
        ks_l.append(k); vs_l.append(v); lfs_l.append(logf); ps_l.append(ext[:, -POOL_HIST:])

    y_prompt = _rms_norm(hp, g_final)
    y_sample = _rms_norm(hs, g_final)
    k_prompt = jnp.stack(kp_l)
    v_prompt = jnp.stack(vp_l)
    logf_prompt = jnp.stack(lfp_l)
    pool_prompt = jnp.stack(pp_l)
    k_sample = jnp.stack(ks_l)
    v_sample = jnp.stack(vs_l)
    logf_sample = jnp.stack(lfs_l)
    pool_sample = jnp.stack(ps_l)
    return (y_prompt, y_sample, k_prompt, v_prompt, logf_prompt, pool_prompt, k_sample, v_sample, logf_sample, pool_sample)
```

```cpp
#include <hip/hip_runtime.h>
#include <hip/hip_bf16.h>
#include <hip/hip_cooperative_groups.h>
#include <cstdio>
#include <cstdint>
#include <cmath>
namespace cg = cooperative_groups;

constexpr int DM = 2048, SEQ = 8192, NB = 4, MP = NB * SEQ, SBATCH = 16, ST = 32, MS = SBATCH * ST, MTOT = MP + MS, PAST = 1024;
constexpr int NH = 8, HD = 128, FOXW = 1024, POOLW = 1024, DFF = 5632, INW = 4104, INWP = 4352, PHIST = 15;
constexpr float EPS = 1e-6f;
constexpr size_t O_Y = 0, O_KP = 68157440, O_VP = 101711872, O_LFP = 135266304, O_PP = 135528448, O_KS = 135589888, O_VS = 136114176, O_LFS = 136638464, O_PS = 136642560, O_END = 136888320;
constexpr size_t MiB = 1u << 20;
constexpr size_t WS_ROWSS = 1 * MiB;
constexpr size_t WS_WGU1 = 2 * MiB, WS_WD1 = 46 * MiB, WS_WIN = 68 * MiB, WS_WO = 85 * MiB, WS_WGU2 = 93 * MiB, WS_WD2 = 137 * MiB, WS_WPOOL = 159 * MiB;
constexpr size_t WS_ABUF = 160 * MiB;
constexpr size_t WS_H = 290 * MiB;
constexpr size_t WS_Q = 290 * MiB, WS_K = 355 * MiB, WS_V = 420 * MiB, WS_P = 485 * MiB;
constexpr size_t WS_D = 648 * MiB, WS_MIX = 713 * MiB, WS_C = 843 * MiB, WS_SPLIT = 848 * MiB, WS_END = 904 * MiB;
constexpr size_t WS_NQ2 = 844 * MiB, WS_NK2 = 846 * MiB;
constexpr size_t WS_QUEUE = 20480, WS_QN = 24576, WS_KN = 32768;
constexpr size_t WS_SPLITCNT = 16384;
constexpr int N_SPLIT_SLOTS = 224;

constexpr int LDS_BYTES = 147456;

typedef unsigned short bf16_t;
typedef short bf16x8 __attribute__((ext_vector_type(8)));
typedef short s16x4 __attribute__((ext_vector_type(4)));
typedef float f32x4 __attribute__((ext_vector_type(4)));
typedef float f32x16 __attribute__((ext_vector_type(16)));
typedef unsigned u32x4 __attribute__((ext_vector_type(4)));
typedef unsigned u32x2 __attribute__((ext_vector_type(2)));

struct Args {
    const float* in[21];
    float* out; unsigned char* ws;
    int ph_lo, ph_hi;
};

__device__ __forceinline__ unsigned cvt_pk_bf16(float lo, float hi) { unsigned r; asm volatile("v_cvt_pk_bf16_f32 %0, %1, %2" : "=v"(r) : "v"(lo), "v"(hi)); return r; }
__device__ __forceinline__ float ld_agent(const float* p) { return __hip_atomic_load(p, __ATOMIC_RELAXED, __HIP_MEMORY_SCOPE_AGENT); }
__device__ __forceinline__ float rstd_of(const float* rowss, int row) { return 1.0f / sqrtf(ld_agent(rowss + row) * (1.0f / DM) + EPS); }

namespace pg8 {
#define PG8_LAS __attribute__((address_space(3)))
constexpr int BM = 256, BK = 64, HALF = 128, HTB = HALF * BK * 2, STAGE_BYTES = 8 * HTB, NXCD = 8, WGM = 8;
__host__ __device__ __forceinline__ int lds_byte(int r, int c) { const int st = (r >> 4) * 2 + (c >> 5), rr = r & 15, cc = c & 31, ob = rr * 64 + cc * 2; return st * 1024 + (ob ^ (((ob >> 9) & 1) << 5)); }
__host__ __device__ __forceinline__ void stage_rc(int b, int& R, int& C) { const int st = b / 1024, sb = b % 1024, swz = sb ^ (((sb >> 9) & 1) << 5); R = (st >> 1) * 16 + swz / 64; C = (st & 1) * 32 + (swz % 64) / 2; }
__host__ __device__ __forceinline__ int perm32(int rho) { const int n = rho >> 4, i = rho & 15; return 8 * (i >> 2) + 4 * n + (i & 3); }
struct Unit { int pm, pn, k0, nk, slot; };
struct Gemm { const bf16_t* A; const bf16_t* Bt; int M, N, K, lda, apn; };
struct StaticOrder {
    int nM, nN, nwg, G, c, ntk, nfull, R, SK, slot0, wgm; float* scratch; unsigned* cnt;
    __host__ __device__ __forceinline__ void init(int M, int N, int K, int G_, int c_, int slot0_, float* scratch_, unsigned* cnt_) { nM = M / BM; nN = N / BM; nwg = nM * nN; G = G_; c = c_; ntk = K / BK; slot0 = slot0_; scratch = scratch_; cnt = cnt_; wgm = (nN == 8) ? 4 : WGM;
        nfull = (nwg / G) * G; R = nwg - nfull; SK = 1;
        if (R > 0 && scratch_) { while (SK < 4 && R * SK * 2 <= G && (ntk / (SK * 2)) % 2 == 0 && ntk / (SK * 2) >= 4) SK *= 2; } }
    __host__ __device__ __forceinline__ void map(int L, Unit& u) const {
        int wgid = L; { const int q = nwg / NXCD, r = nwg % NXCD, xcd = wgid % NXCD, off = wgid / NXCD; wgid = (xcd < r ? xcd * (q + 1) : r * (q + 1) + (xcd - r) * q) + off; }
        const int nig = wgm * nN, gid = wgid / nig, fm = gid * wgm, gsz = (nM - fm) < wgm ? (nM - fm) : wgm;
        u.pm = fm + ((wgid % nig) % gsz); u.pn = (wgid % nig) / gsz; }
    __host__ __device__ __forceinline__ bool next(int i, Unit& u) const {
        const int rf = nfull / G;
        if (i < rf) { map(i * G + c, u); u.k0 = 0; u.nk = ntk; u.slot = -1; return true; }
        if (i > rf) return false;
        if (SK == 1) { const int L = nfull + c; if (L >= nwg) return false; map(L, u); u.k0 = 0; u.nk = ntk; u.slot = -1; return true; }
        if (c >= R * SK) return false;
        const int ui = c / SK, part = c % SK; map(nfull + ui, u); u.nk = ntk / SK; u.k0 = part * u.nk; u.slot = slot0 + ui; return true;
    }
};
template <class Epi> __device__ __forceinline__ void epi_all(const Epi& E, const f32x4 (&acc)[2][2][4][2], const Unit& u, int wr, int wc, int fr, int fq, const float (&rsq)[8]);
template <class Epi>
__device__ __forceinline__ void gemm_phase(PG8_LAS unsigned char* lds, const Gemm g, const StaticOrder& S, const Epi& E) {
    int tid_ = threadIdx.x; asm volatile("" : "+v"(tid_)); const int tid = tid_, wid = __builtin_amdgcn_readfirstlane(tid >> 6), lane = tid & 63, wr = wid >> 2, wc = wid & 3, fr = lane & 15, fq = lane >> 4;
    const int K = g.K;
    unsigned voffA[2], voffB[2];
#pragma unroll
    for (int i = 0; i < 2; ++i) { int R, C; stage_rc(tid * 16 + i * 8192, R, C); const int Rb = (R & ~31) + perm32(R & 31);
        voffA[i] = (unsigned)(R * g.lda + C) * 2u; voffB[i] = (unsigned)(Rb * K + C) * 2u; }
    const size_t kstep = (size_t)(BK * 2);
    const size_t hstepA = (size_t)HALF * g.lda * 2, hstepB = (size_t)HALF * K * 2;
    const size_t tstepA = 2 * hstepA, tstepB = 2 * hstepB;
    const unsigned ldsw = (unsigned)wid * 1024u;
    const int aoff = lds_byte(wr * 64 + fr, fq * 8), boff = lds_byte(wc * 32 + fr, fq * 8);
#define PG8_SA(b, h) (((b) * 2 + (h)) * HTB)
#define PG8_SB(b, h) ((4 + (b) * 2 + (h)) * HTB)
#define PG8_STAGE(bufoff, gbase, voff) do { _Pragma("unroll") for (int _i = 0; _i < 2; ++_i) \
        __builtin_amdgcn_global_load_lds((const unsigned*)((const char*)(gbase) + (voff)[_i]), (PG8_LAS unsigned*)(lds + (bufoff) + ldsw + _i * 8192), 16, 0, 0); } while (0)
#define PG8_LDA(dst, b, h) do { _Pragma("unroll") for (int m = 0; m < 4; ++m) _Pragma("unroll") for (int k = 0; k < 2; ++k) dst[m][k] = *(const PG8_LAS bf16x8*)(lds + PG8_SA(b, h) + aoff + m * 2048 + k * 1024); } while (0)
#define PG8_LDB(dst, b, h) do { _Pragma("unroll") for (int n = 0; n < 2; ++n) _Pragma("unroll") for (int k = 0; k < 2; ++k) dst[n][k] = *(const PG8_LAS bf16x8*)(lds + PG8_SB(b, h) + boff + n * 2048 + k * 1024); } while (0)
#define PG8_MMA(ai, bj, At, Bt) do { __builtin_amdgcn_s_setprio(1); _Pragma("unroll") for (int m = 0; m < 4; ++m) _Pragma("unroll") for (int n = 0; n < 2; ++n) _Pragma("unroll") for (int k = 0; k < 2; ++k) \
        acc[ai][bj][m][n] = __builtin_amdgcn_mfma_f32_16x16x32_bf16(Bt[n][k], At[m][k], acc[ai][bj][m][n], 0, 0, 0); __builtin_amdgcn_s_setprio(0); } while (0)
#define PG8_WAIT_V(n) asm volatile("s_waitcnt vmcnt(" #n ")" ::: "memory")
#define PG8_WAIT_L(n) asm volatile("s_waitcnt lgkmcnt(" #n ")" ::: "memory")
#define PG8_BAR __builtin_amdgcn_s_barrier()
#define PG8_SCHED __builtin_amdgcn_sched_barrier(0)
    Unit cur, nxt; int ui = 0;
    if (!S.next(0, cur)) return;
    f32x4 acc[2][2][4][2];
#pragma unroll
    for (int a = 0; a < 2; ++a)
#pragma unroll
        for (int b = 0; b < 2; ++b)
#pragma unroll
            for (int m = 0; m < 4; ++m)
#pragma unroll
                for (int n = 0; n < 2; ++n) acc[a][b][m][n] = (f32x4){0.f, 0.f, 0.f, 0.f};
    bf16x8 At[4][2], B0[2][2], B1[2][2];
    const char* cA = (const char*)g.A + (size_t)cur.pm * tstepA + (size_t)cur.pn * g.apn * 2 + (size_t)cur.k0 * kstep; const char* cB = (const char*)g.Bt + (size_t)cur.pn * tstepB + (size_t)cur.k0 * kstep;
    PG8_STAGE(PG8_SB(0, 0), cB, voffB); PG8_STAGE(PG8_SB(0, 1), cB + hstepB, voffB); PG8_STAGE(PG8_SA(0, 0), cA, voffA); PG8_STAGE(PG8_SA(0, 1), cA + hstepA, voffA);
    if (wr == 1) PG8_BAR;
    PG8_WAIT_V(2); PG8_BAR;
    PG8_STAGE(PG8_SB(1, 0), cB + kstep, voffB); PG8_STAGE(PG8_SA(1, 0), cA + kstep, voffA); PG8_STAGE(PG8_SB(1, 1), cB + hstepB + kstep, voffB);
    PG8_WAIT_V(6); PG8_BAR;
    for (;;) {
        const bool has_next = S.next(ui + 1, nxt);
        const char* nA = has_next ? (const char*)g.A + (size_t)nxt.pm * tstepA + (size_t)nxt.pn * g.apn * 2 + (size_t)nxt.k0 * kstep : cA; const char* nB = has_next ? (const char*)g.Bt + (size_t)nxt.pn * tstepB + (size_t)nxt.k0 * kstep : cB;
        const int nt = cur.nk;
        float rsq[8]; E.pre(cur, wr, fr, rsq);
        for (int t = 0; t < nt; t += 2) {
            const bool last = (t == nt - 2);
            const char* a1 = cA + (size_t)(t + 1) * kstep;
            const char* a2 = last ? nA : cA + (size_t)(t + 2) * kstep; const char* b2 = last ? nB : cB + (size_t)(t + 2) * kstep;
            const char* a3 = a2 + kstep; const char* b3 = b2 + kstep;
            PG8_LDB(B0, 0, 0); PG8_LDB(B1, 0, 1); PG8_SCHED; PG8_LDA(At, 0, 0); PG8_STAGE(PG8_SA(1, 1), a1 + hstepA, voffA);
            PG8_WAIT_V(8); PG8_WAIT_L(0); PG8_BAR; PG8_MMA(0, 0, At, B0); PG8_MMA(0, 1, At, B1); PG8_BAR; PG8_SCHED;
            PG8_LDA(At, 0, 1); PG8_STAGE(PG8_SB(0, 0), b2, voffB); PG8_STAGE(PG8_SB(0, 1), b2 + hstepB, voffB); PG8_STAGE(PG8_SA(0, 0), a2, voffA);
            PG8_WAIT_V(8); PG8_WAIT_L(0); PG8_BAR; PG8_MMA(1, 0, At, B0); PG8_MMA(1, 1, At, B1); PG8_BAR; PG8_SCHED;
            PG8_LDB(B0, 1, 0); PG8_LDB(B1, 1, 1); PG8_SCHED; PG8_LDA(At, 1, 0); PG8_STAGE(PG8_SA(0, 1), a2 + hstepA, voffA);
            PG8_WAIT_V(8); PG8_WAIT_L(0); PG8_BAR; PG8_MMA(0, 0, At, B0); PG8_MMA(0, 1, At, B1); PG8_BAR; PG8_SCHED;
            PG8_LDA(At, 1, 1); PG8_STAGE(PG8_SB(1, 0), b3, voffB); PG8_STAGE(PG8_SB(1, 1), b3 + hstepB, voffB); PG8_STAGE(PG8_SA(1, 0), a3, voffA);
            PG8_WAIT_V(8); PG8_WAIT_L(0); PG8_BAR; PG8_MMA(1, 0, At, B0); PG8_MMA(1, 1, At, B1); PG8_BAR; PG8_SCHED;
        }
        if (wr == 0) PG8_BAR;
        if (cur.slot < 0) epi_all(E, acc, cur, wr, wc, fr, fq, rsq);
        else {
            const size_t lane_off = (size_t)(wr * 64 + fr) * BM + wc * 32 + 8 * fq;
            { float* mine = S.scratch + (size_t)((cur.slot - S.slot0) * S.SK + cur.k0 / cur.nk) * (BM * BM) + lane_off;
#pragma unroll
              for (int ai = 0; ai < 2; ++ai)
#pragma unroll
                for (int m = 0; m < 4; ++m) { __attribute__((address_space(1))) float* p = (__attribute__((address_space(1))) float*)(mine + (ai * HALF + m * 16) * BM); asm volatile("" : "+v"(p));
#pragma unroll
                    for (int bj = 0; bj < 2; ++bj) { *(__attribute__((address_space(1))) f32x4*)(p + bj * HALF) = acc[ai][bj][m][0]; *(__attribute__((address_space(1))) f32x4*)(p + bj * HALF + 4) = acc[ai][bj][m][1]; } } }
            asm volatile("s_waitcnt vmcnt(0)" ::: "memory"); PG8_BAR;
            PG8_LAS unsigned* flag = (PG8_LAS unsigned*)(lds + 131072 + 128);
            if (tid == 0) { __builtin_amdgcn_fence(__ATOMIC_RELEASE, "agent"); asm volatile("s_waitcnt vmcnt(0)" ::: "memory");
                *flag = __hip_atomic_fetch_add(S.cnt + cur.slot, 1u, __ATOMIC_RELAXED, __HIP_MEMORY_SCOPE_AGENT); }
            asm volatile("s_waitcnt vmcnt(0) lgkmcnt(0)" ::: "memory"); PG8_BAR; asm volatile("" ::: "memory");
            const unsigned old = *flag;
            if (old == (unsigned)(S.SK - 1)) {
                __builtin_amdgcn_fence(__ATOMIC_ACQUIRE, "agent");
                asm volatile("s_waitcnt vmcnt(0)" ::: "memory");
                const float* base = S.scratch + (size_t)((cur.slot - S.slot0) * S.SK) * (BM * BM) + lane_off;
                const int row0 = cur.pm * BM + wr * 64 + fr;
#pragma unroll
                for (int ai = 0; ai < 2; ++ai)
#pragma unroll
                    for (int m = 0; m < 4; ++m) {
                        f32x4 v[2][2] = {{{0.f, 0.f, 0.f, 0.f}, {0.f, 0.f, 0.f, 0.f}}, {{0.f, 0.f, 0.f, 0.f}, {0.f, 0.f, 0.f, 0.f}}};
                        for (int q = 0; q < S.SK; ++q) { const __attribute__((address_space(1))) float* p = (const __attribute__((address_space(1))) float*)(base + (size_t)q * (BM * BM) + (ai * HALF + m * 16) * BM); asm volatile("" : "+v"(p));
#pragma unroll
                            for (int bj = 0; bj < 2; ++bj) { v[bj][0] += *(const __attribute__((address_space(1))) f32x4*)(p + bj * HALF); v[bj][1] += *(const __attribute__((address_space(1))) f32x4*)(p + bj * HALF + 4); } }
                        E.row(v, cur, row0 + ai * HALF + m * 16, wc, fq, rsq[ai * 4 + m]);
                        asm volatile("" ::: "memory"); }
            }
        }
        if (!has_next) break;
#pragma unroll
        for (int a = 0; a < 2; ++a)
#pragma unroll
            for (int b = 0; b < 2; ++b)
#pragma unroll
                for (int m = 0; m < 4; ++m)
#pragma unroll
                    for (int n = 0; n < 2; ++n) acc[a][b][m][n] = (f32x4){0.f, 0.f, 0.f, 0.f};
        cur = nxt; cA = nA; cB = nB; ++ui;
        if (wr == 1) PG8_BAR;
    }
    PG8_WAIT_V(0);
    PG8_BAR;
#undef PG8_SA
#undef PG8_SB
#undef PG8_STAGE
#undef PG8_LDA
#undef PG8_LDB
#undef PG8_MMA
#undef PG8_WAIT_V
#undef PG8_WAIT_L
#undef PG8_BAR
#undef PG8_SCHED
}

template <class Epi> __device__ __forceinline__ void epi_all(const Epi& E, const f32x4 (&acc)[2][2][4][2], const Unit& u, int wr, int wc, int fr, int fq, const float (&rsq)[8]) {
    const int row0 = u.pm * BM + wr * 64 + fr;
#pragma unroll
    for (int ai = 0; ai < 2; ++ai)
#pragma unroll
        for (int m = 0; m < 4; ++m) { const f32x4 v[2][2] = {{acc[ai][0][m][0], acc[ai][0][m][1]}, {acc[ai][1][m][0], acc[ai][1][m][1]}}; E.row(v, u, row0 + ai * HALF + m * 16, wc, fq, rsq[ai * 4 + m]); }
}
__device__ __forceinline__ float silu_mul(float g, float u) { return g * __builtin_amdgcn_rcpf(1.0f + __builtin_amdgcn_exp2f(-1.4426950408889634f * g)) * u; }
typedef float f32x2 __attribute__((ext_vector_type(2)));
__device__ __forceinline__ f32x2 silu_mul2(f32x2 g, f32x2 u) {
    f32x2 x = g * (-1.4426950408889634f); x.x = fminf(x.x, 60.f); x.y = fminf(x.y, 60.f);
    f32x2 e; e.x = __builtin_amdgcn_exp2f(x.x); e.y = __builtin_amdgcn_exp2f(x.y);
    const f32x2 d = e + 1.0f; const float r = __builtin_amdgcn_rcpf(d.x * d.y);
    const f32x2 sg = (f32x2){d.y, d.x} * r;
    return (g * u) * sg;
}
struct EpiGU {
    bf16_t* H; const float* rowss;
    __device__ __forceinline__ void pre(const Unit& u, int wr, int fr, float (&r)[8]) const {
#pragma unroll
        for (int i = 0; i < 8; ++i) r[i] = rowss ? ld_agent(rowss + u.pm * BM + wr * 64 + fr + (i >> 2) * HALF + (i & 3) * 16) : 0.f; }
    __device__ __forceinline__ void row(const f32x4 (&v)[2][2], const Unit& u, int row, int wc, int fq, float rq) const {
        const int col0 = u.pn * 128 + wc * 32 + 8 * fq; const float rs = rowss ? 1.0f / sqrtf(rq * (1.0f / DM) + EPS) : 1.0f;
        const f32x4 g0 = v[0][0] * rs, g1 = v[0][1] * rs, u0 = v[1][0] * rs, u1 = v[1][1] * rs;
        const f32x2 a = silu_mul2((f32x2){g0[0], g0[1]}, (f32x2){u0[0], u0[1]}), b = silu_mul2((f32x2){g0[2], g0[3]}, (f32x2){u0[2], u0[3]});
        const f32x2 c = silu_mul2((f32x2){g1[0], g1[1]}, (f32x2){u1[0], u1[1]}), d = silu_mul2((f32x2){g1[2], g1[3]}, (f32x2){u1[2], u1[3]});
        u32x4 w; w.x = cvt_pk_bf16(a.x, a.y); w.y = cvt_pk_bf16(b.x, b.y); w.z = cvt_pk_bf16(c.x, c.y); w.w = cvt_pk_bf16(d.x, d.y);
        *(u32x4*)(H + (size_t)row * DFF + col0) = w;
    }
};
struct EpiRes {
    const float* resid_p; const float* resid_s; const bf16_t* rbf; float alpha; bf16_t* hb; float* rowss;
    __device__ __forceinline__ void pre(const Unit&, int, int, float (&r)[8]) const {
#pragma unroll
        for (int i = 0; i < 8; ++i) r[i] = 0.f; }
    __device__ __forceinline__ void row(const f32x4 (&v)[2][2], const Unit& u, int row, int wc, int fq, float) const {
        const int col0 = u.pn * BM + wc * 32 + 8 * fq;
        const float* rbase = (u.pm < MP / BM) ? resid_p : resid_s - (size_t)MP * DM;
        const size_t off = (size_t)row * DM + col0; float ss = 0.f;
#pragma unroll
        for (int bj = 0; bj < 2; ++bj) {
            f32x4 r0, r1;
            if (rbf) { const u32x4 w = *(const u32x4*)(rbf + off + bj * HALF);
                r0 = (f32x4){__uint_as_float(w.x << 16), __uint_as_float(w.x & 0xffff0000u), __uint_as_float(w.y << 16), __uint_as_float(w.y & 0xffff0000u)};
                r1 = (f32x4){__uint_as_float(w.z << 16), __uint_as_float(w.z & 0xffff0000u), __uint_as_float(w.w << 16), __uint_as_float(w.w & 0xffff0000u)}; }
            else { r0 = *(const f32x4*)(rbase + off + bj * HALF); r1 = *(const f32x4*)(rbase + off + bj * HALF + 4); }
            const f32x4 v0 = r0 + v[bj][0] * alpha, v1 = r1 + v[bj][1] * alpha;
            ss += (v0[0] * v0[0] + v0[1] * v0[1]) + (v0[2] * v0[2] + v0[3] * v0[3]) + (v1[0] * v1[0] + v1[1] * v1[1]) + (v1[2] * v1[2] + v1[3] * v1[3]);
            u32x4 w; w.x = cvt_pk_bf16(v0[0], v0[1]); w.y = cvt_pk_bf16(v0[2], v0[3]); w.z = cvt_pk_bf16(v1[0], v1[1]); w.w = cvt_pk_bf16(v1[2], v1[3]);
            *(u32x4*)(hb + off + bj * HALF) = w; }
        ss += __shfl_xor(ss, 16); ss += __shfl_xor(ss, 32);
        if (fq == 0) atomicAdd(rowss + row, ss);
    }
};
__device__ __forceinline__ float log_sigmoid(float z) { return fminf(z, 0.f) - log1pf(expf(-fabsf(z))); }
struct EpiIn {
    const float* rowss; float* out; bf16_t* Qb; bf16_t* Kb; bf16_t* Vb; float* Pb; const float* bfp; float* NQ2; float* NK2;
    __device__ __forceinline__ void pre(const Unit& u, int wr, int fr, float (&r)[8]) const {
#pragma unroll
        for (int i = 0; i < 8; ++i) r[i] = ld_agent(rowss + u.pm * BM + wr * 64 + fr + (i >> 2) * HALF + (i & 3) * 16); }
    __device__ __forceinline__ void row(const f32x4 (&v)[2][2], const Unit& u, int row, int wc, int fq, float rq) const {
        const int sec = u.pn >> 2, cbase = (u.pn & 3) * BM + wc * 32 + 8 * fq; const bool samp = u.pm >= MP / BM;
        const float rs = 1.0f / sqrtf(rq * (1.0f / DM) + EPS);
        size_t hm; int hs;
        if (!samp) { const int b = row >> 13, t = row & (SEQ - 1); hm = ((size_t)b * NH * SEQ + t) * HD; hs = SEQ * HD; }
        else { const int ms = row - MP, b = ms >> 5, t = ms & 31; hm = (size_t)MP * FOXW + ((size_t)b * NH * ST + t) * HD; hs = ST * HD; }
#pragma unroll
        for (int bj = 0; bj < 2; ++bj) { const int col = cbase + bj * HALF; const f32x4 v0 = v[bj][0] * rs, v1 = v[bj][1] * rs;
            const int h = col >> 7, d = col & 127;
            if (sec < 2 && !samp) { float ss = (v0[0] * v0[0] + v0[1] * v0[1]) + (v0[2] * v0[2] + v0[3] * v0[3]) + (v1[0] * v1[0] + v1[1] * v1[1]) + (v1[2] * v1[2] + v1[3] * v1[3]);
                ss += __shfl_xor(ss, 16); ss += __shfl_xor(ss, 32); if (fq == 0) atomicAdd((sec == 0 ? NQ2 : NK2) + (size_t)row * NH + h, ss); }
            if (sec == 0) { u32x4 w; w.x = cvt_pk_bf16(v0[0], v0[1]); w.y = cvt_pk_bf16(v0[2], v0[3]); w.z = cvt_pk_bf16(v1[0], v1[1]); w.w = cvt_pk_bf16(v1[2], v1[3]);
                *(u32x4*)(Qb + hm + (size_t)h * hs + d) = w; }
            else if (sec == 1 || sec == 2) {
                float* o = out + (samp ? (sec == 1 ? O_KS : O_VS) + (size_t)(row - MP) * FOXW : (sec == 1 ? O_KP : O_VP) + (size_t)row * FOXW) + col;
                *(f32x4*)o = v0; *(f32x4*)(o + 4) = v1;
                if (!samp) { u32x4 w; w.x = cvt_pk_bf16(v0[0], v0[1]); w.y = cvt_pk_bf16(v0[2], v0[3]); w.z = cvt_pk_bf16(v1[0], v1[1]); w.w = cvt_pk_bf16(v1[2], v1[3]);
                    *(u32x4*)((sec == 1 ? Kb : Vb) + hm + (size_t)h * hs + d) = w; } }
            else if (sec == 3) { float* o = Pb + (size_t)row * POOLW + col; *(f32x4*)o = v0; *(f32x4*)(o + 4) = v1; }
            else { if (bj == 0 && wc == 0 && fq == 0) { float* o = out + (samp ? O_LFS + (size_t)(row - MP) * NH : O_LFP + (size_t)row * NH);
                    f32x4 l0, l1;
#pragma unroll
                    for (int j = 0; j < 4; ++j) { l0[j] = log_sigmoid(v0[j] + bfp[j]); l1[j] = log_sigmoid(v1[j] + bfp[4 + j]); }
                    *(f32x4*)o = l0; *(f32x4*)(o + 4) = l1; } } }
    }
};
struct EpiPool {
    bf16_t* MIX; const float* scale;
    __device__ __forceinline__ void pre(const Unit&, int, int, float (&r)[8]) const {
#pragma unroll
        for (int i = 0; i < 8; ++i) r[i] = 0.f; }
    __device__ __forceinline__ void row(const f32x4 (&v)[2][2], const Unit& u, int row, int wc, int fq, float) const {
        const int col0 = u.pn * BM + wc * 32 + 8 * fq;
#pragma unroll
        for (int bj = 0; bj < 2; ++bj) { const f32x4 v0 = v[bj][0] * *(const f32x4*)(scale + col0 + bj * HALF), v1 = v[bj][1] * *(const f32x4*)(scale + col0 + bj * HALF + 4);
            u32x4 w; w.x = cvt_pk_bf16(v0[0], v0[1]); w.y = cvt_pk_bf16(v0[2], v0[3]); w.z = cvt_pk_bf16(v1[0], v1[1]); w.w = cvt_pk_bf16(v1[2], v1[3]);
            *(u32x4*)(MIX + (size_t)row * DM + FOXW + col0 + bj * HALF) = w; }
    }
};
struct EpiFold {
    bf16_t* WoT;
    __device__ __forceinline__ void pre(const Unit&, int, int, float (&r)[8]) const {
#pragma unroll
        for (int i = 0; i < 8; ++i) r[i] = 0.f; }
    __device__ __forceinline__ void row(const f32x4 (&v)[2][2], const Unit& u, int row, int wc, int fq, float) const {
        const int col0 = FOXW + u.pn * BM + wc * 32 + 8 * fq;
#pragma unroll
        for (int bj = 0; bj < 2; ++bj) { u32x4 w; w.x = cvt_pk_bf16(v[bj][0][0], v[bj][0][1]); w.y = cvt_pk_bf16(v[bj][0][2], v[bj][0][3]); w.z = cvt_pk_bf16(v[bj][1][0], v[bj][1][1]); w.w = cvt_pk_bf16(v[bj][1][2], v[bj][1][3]);
            *(u32x4*)(WoT + (size_t)row * DM + col0 + bj * HALF) = w; }
    }
};
}

namespace fox {
constexpr int D = 128, OST = DM;
constexpr float SCALE = 0.08838834764831845f, INV_SCALE = 11.313708498984761f;
constexpr float THR = 32.f;
constexpr int NW = 8, QBLK = 32, KVBLK = 64, QB = NW * QBLK;
constexpr int SHM_V = KVBLK * D * 2, SHM_K = KVBLK * D * 2;
constexpr int LDS_ATT = 2 * SHM_V + 2 * SHM_K + NW * 64 * 4;
constexpr int LDS_BIAS = 69632;
#define KSWZ(row, colB) ((row) * 256 + ((colB) ^ (((row) & 7) << 4)))
#define SBAR() __builtin_amdgcn_sched_barrier(0)
__device__ __forceinline__ int v_st(int k, int c) { const int kk = (k & ~0xC) | ((k & 4) << 1) | ((k & 8) >> 1); return ((kk >> 3) * 4 + (c >> 5)) * 512 + ((kk & 7) * 32 + (c & 31)) * 2; }
__device__ __forceinline__ int v_rd_base(int lane) { return ((lane & 3) << 3) | (((lane >> 2) & 3) << 6) | (((lane >> 4) & 1) << 5) | (((lane >> 5) & 1) << 8); }
constexpr int v_rd_off(int d0, int ks, int half) { return d0 * 512 + ks * 4096 + half * 2048; }
__device__ __forceinline__ int crow(int r, int hi) { return (r & 3) + 8 * (r >> 2) + 4 * hi; }
__device__ __forceinline__ bf16x8 pack8(f32x4 a, f32x4 b) { u32x4 w = {cvt_pk_bf16(a[0], a[1]), cvt_pk_bf16(a[2], a[3]), cvt_pk_bf16(b[0], b[1]), cvt_pk_bf16(b[2], b[3])}; return *reinterpret_cast<bf16x8*>(&w); }
__device__ __forceinline__ bf16x8 load8h(const bf16_t* p) { return *reinterpret_cast<const bf16x8*>(p); }
__device__ __forceinline__ bf16x8 load8f(const float* p) { return pack8(*(const f32x4*)p, *(const f32x4*)(p + 4)); }
__device__ __forceinline__ void mask_tile(f32x16& p0, f32x16& p1, int dq, unsigned W) {
    const float NEG = -__builtin_inff();
#pragma unroll
    for (int r = 0; r < 16; ++r) { const int c = (r & 3) + 8 * (r >> 2);
        if ((unsigned)(dq - c) >= W) p0[r] = NEG;
        if ((unsigned)(dq - c - 32) >= W) p1[r] = NEG; }
}
__device__ __forceinline__ void partialSM(f32x16& p0, f32x16& p1, float& m_reg, float& mn, float& alpha) {
    float pmax = p0[0];
#pragma unroll
    for (int r = 1; r < 16; ++r) pmax = fmaxf(pmax, p0[r]);
#pragma unroll
    for (int r = 0; r < 16; ++r) pmax = fmaxf(pmax, p1[r]);
    { auto rr = __builtin_amdgcn_permlane32_swap(__float_as_uint(pmax), __float_as_uint(pmax), false, false);
      pmax = fmaxf(__uint_as_float(rr[0]), __uint_as_float(rr[1])); }
    constexpr float C2 = 1.4426950408889634f * SCALE;
    if (__builtin_expect(__all((pmax - m_reg) * SCALE <= THR), 1)) { mn = m_reg; alpha = 1.f; }
    else { mn = fmaxf(m_reg, pmax); alpha = __builtin_amdgcn_exp2f((m_reg - mn) * C2); m_reg = mn; }
    const float mnL = -mn * C2;
#pragma unroll
    for (int r = 0; r < 16; ++r) p0[r] = fmaf(p0[r], C2, mnL);
#pragma unroll
    for (int r = 0; r < 16; ++r) p1[r] = fmaf(p1[r], C2, mnL);
#pragma unroll
    for (int r = 0; r < 16; ++r) p0[r] = __builtin_amdgcn_exp2f(p0[r]);
}
__device__ __forceinline__ void finishSM(f32x16& p0, f32x16& p1, float alpha, float& l_reg, bf16x8& pa0, bf16x8& pa1, bf16x8& pa2, bf16x8& pa3) {
#pragma unroll
    for (int r = 0; r < 16; ++r) p1[r] = __builtin_amdgcn_exp2f(p1[r]);
    float ps = 0;
#pragma unroll
    for (int r = 0; r < 16; ++r) ps += p0[r];
#pragma unroll
    for (int r = 0; r < 16; ++r) ps += p1[r];
    { auto rr = __builtin_amdgcn_permlane32_swap(__float_as_uint(ps), __float_as_uint(ps), false, false);
      ps = __uint_as_float(rr[0]) + __uint_as_float(rr[1]); }
    l_reg = l_reg * alpha + ps;
#define PK4(P, B_, OUT) do { unsigned a0 = cvt_pk_bf16(P[B_+0], P[B_+1]), a1 = cvt_pk_bf16(P[B_+2], P[B_+3]);                          \
        unsigned b0 = cvt_pk_bf16(P[B_+4], P[B_+5]), b1 = cvt_pk_bf16(P[B_+6], P[B_+7]);                                             \
        auto r0 = __builtin_amdgcn_permlane32_swap(a0, b0, false, false); auto r1 = __builtin_amdgcn_permlane32_swap(a1, b1, false, false); \
        u32x4 w = {r0[0], r1[0], r0[1], r1[1]}; OUT = *reinterpret_cast<bf16x8*>(&w); } while (0)
    PK4(p0, 0, pa0); PK4(p0, 8, pa1); PK4(p1, 0, pa2); PK4(p1, 8, pa3);
#undef PK4
}
typedef __attribute__((address_space(3))) const float* lds_cf;
__device__ __forceinline__ void bias_init(f32x16& p0, f32x16& p1, lds_cf bt) {
#pragma unroll
    for (int g = 0; g < 4; ++g) { const f32x4 a = *(const __attribute__((address_space(3))) f32x4*)(bt + 8 * g), b = *(const __attribute__((address_space(3))) f32x4*)(bt + 32 + 8 * g);
        p0[4 * g] = a[0]; p0[4 * g + 1] = a[1]; p0[4 * g + 2] = a[2]; p0[4 * g + 3] = a[3];
        p1[4 * g] = b[0]; p1[4 * g + 1] = b[1]; p1[4 * g + 2] = b[2]; p1[4 * g + 3] = b[3]; }
}
template <int KB>
__device__ __forceinline__ void qkt(f32x16& p0, f32x16& p1, const char* K_lds, int r32, int hi, const bf16x8* qr, lds_cf bt) {
    bias_init(p0, p1, bt);
    const char* kb[4];
#pragma unroll
    for (int dd = 0; dd < 4; ++dd) kb[dd] = K_lds + KB * SHM_K + KSWZ(r32, (dd * 16 + hi * 8) * 2);
#pragma unroll
    for (int d0 = 0; d0 < 8; ++d0) { const char* a = kb[d0 & 3] + (d0 >> 2) * 128;
        bf16x8 b0 = *reinterpret_cast<const bf16x8*>(a);
        bf16x8 b1 = *reinterpret_cast<const bf16x8*>(a + 32 * 256);
        p0 = __builtin_amdgcn_mfma_f32_32x32x16_bf16(b0, qr[d0], p0, 0, 0, 0);
        p1 = __builtin_amdgcn_mfma_f32_32x32x16_bf16(b1, qr[d0], p1, 0, 0, 0); }
}
template <int VB>
__device__ __forceinline__ void pv_tile(f32x16* o, int vb0, bf16x8 pa0, bf16x8 pa1, bf16x8 pa2, bf16x8 pa3) {
#define TRRD(dst, off) asm volatile("ds_read_b64_tr_b16 %0, %1 offset:%2" : "=&v"(dst) : "v"(vb0), "i"(off) : "memory")
#define PV_D0(d0) do { s16x4 l0, l1, l2, l3, h0, h1, h2, h3; constexpr int b_ = VB * SHM_V + v_rd_off(d0, 0, 0); \
        TRRD(l0, b_); TRRD(h0, b_ + 2048); TRRD(l1, b_ + 4096); TRRD(h1, b_ + 6144); TRRD(l2, b_ + 8192); TRRD(h2, b_ + 10240); TRRD(l3, b_ + 12288); TRRD(h3, b_ + 14336); \
        asm volatile("s_waitcnt lgkmcnt(0)" ::: "memory"); SBAR();   \
        o[d0] = __builtin_amdgcn_mfma_f32_32x32x16_bf16(pa0, (bf16x8){l0[0], l0[1], l0[2], l0[3], h0[0], h0[1], h0[2], h0[3]}, o[d0], 0, 0, 0);   \
        o[d0] = __builtin_amdgcn_mfma_f32_32x32x16_bf16(pa1, (bf16x8){l1[0], l1[1], l1[2], l1[3], h1[0], h1[1], h1[2], h1[3]}, o[d0], 0, 0, 0);   \
        o[d0] = __builtin_amdgcn_mfma_f32_32x32x16_bf16(pa2, (bf16x8){l2[0], l2[1], l2[2], l2[3], h2[0], h2[1], h2[2], h2[3]}, o[d0], 0, 0, 0);   \
        o[d0] = __builtin_amdgcn_mfma_f32_32x32x16_bf16(pa3, (bf16x8){l3[0], l3[1], l3[2], l3[3], h3[0], h3[1], h3[2], h3[3]}, o[d0], 0, 0, 0); } while (0)
    PV_D0(0); PV_D0(1); PV_D0(2); PV_D0(3);
#undef PV_D0
#undef TRRD
}
struct BlockRef { const bf16_t* K; bf16_t* O; const float* C; int P0; float nrm;
    __device__ __forceinline__ const bf16_t* Vp() const { return K + (WS_V - WS_K) / 2; }
    __device__ __forceinline__ const bf16_t* Qp() const { return K - (WS_K - WS_Q) / 2 + (size_t)P0 * D; } };
struct Seam { bf16x8 qr[8]; bf16x8 st_v0, st_v1, st_k0, st_k1; };
#define ROW(p, k0, rr) ((p) + (size_t)((k0) + (rr)) * D + sc)
#define VMW() asm volatile("s_waitcnt vmcnt(0)" ::: "memory")
#define VMWN(n) asm volatile("s_waitcnt vmcnt(%0)" :: "i"(n) : "memory")
#define SLOAD_H(Kp, Vp, k0) do { S.st_v0 = load8h(ROW(Vp, k0, sr)); S.st_v1 = load8h(ROW(Vp, k0, 32 + sr));              \
                         S.st_k0 = load8h(ROW(Kp, k0, sr)); S.st_k1 = load8h(ROW(Kp, k0, 32 + sr)); } while (0)
#define SWRITE_HK(bf) do { *(bf16x8*)(K_lds + (bf) * SHM_K + kws) = S.st_k0; *(bf16x8*)(K_lds + (bf) * SHM_K + kws + 32 * 256) = S.st_k1; } while (0)
#define SWRITE_HV(bf) do { *(bf16x8*)(V_lds + (bf) * SHM_V + vst0) = S.st_v0; *(bf16x8*)(V_lds + (bf) * SHM_V + vst1) = S.st_v1; } while (0)
#define SWRITE_H(bf) do { SWRITE_HV(bf); SWRITE_HK(bf); } while (0)
__device__ __forceinline__ void prime(const BlockRef& cur, char* lds, Seam& S) {
    int tid_ = threadIdx.x; asm volatile("" : "+v"(tid_)); const int tid = tid_, wid = __builtin_amdgcn_readfirstlane(tid >> 6), lane = tid & 63, r32 = lane & 31, hi = lane >> 5;
#pragma unroll
    for (int d0 = 0; d0 < 8; ++d0) S.qr[d0] = load8h(cur.Qp() + (size_t)(wid * QBLK + r32) * D + d0 * 16 + hi * 8);
    __syncthreads();
}
__device__ __forceinline__ void block(const BlockRef& cur, const BlockRef& nxt, char* lds, Seam& S) {
    int tid_ = threadIdx.x; asm volatile("" : "+v"(tid_)); const int tid = tid_, wid = __builtin_amdgcn_readfirstlane(tid >> 6), lane = tid & 63, r32 = lane & 31, hi = lane >> 5;
    const int NTC = (cur.P0 + QB) / KVBLK;
    const unsigned W = 0x40000000u;
    const int qlo = cur.P0 + wid * QBLK, qm = qlo + r32 - 4 * hi;
    char* V_lds = lds; char* K_lds = lds + 2 * SHM_V;
    float* ws = (float*)(lds + 2 * SHM_V + 2 * SHM_K) + wid * 64; float* li_l = ws, * al_l = ws + 32;
    float* bias = (float*)(lds + LDS_BIAS);
    { const float cref = cur.C[cur.P0]; const int n4 = (cur.P0 + QB) >> 2; int tl = threadIdx.x; asm volatile("" : "+v"(tl));
      for (int i = tl; i < n4; i += 512) { const f32x4 c4 = *(const f32x4*)(cur.C + 4 * i); *(f32x4*)(bias + 4 * i) = (cref - c4) * INV_SCALE; } }
    __syncthreads();
    int* jl = (int*)(lds + LDS_BIAS - 16);
    if (wid == 0) { const float lim = -(88.0f + 2.0f * cur.nrm) * INV_SCALE; const int t1 = lane + 64;
        const bool d0 = lane < NTC && bias[64 * lane + 63] < lim, d1 = t1 < NTC && bias[64 * t1 + 63] < lim;
        int cnt = __popcll(__ballot(d0)) + __popcll(__ballot(d1)); cnt &= ~1; if (cnt > NTC - 4) cnt = NTC - 4;
        if (lane == 0) *jl = cnt; }
    __syncthreads();
    const int j_lo = __builtin_amdgcn_readfirstlane(*jl), NT = NTC - j_lo;
    const lds_cf bt0 = (lds_cf)(__attribute__((address_space(3))) char*)lds + LDS_BIAS / 4 + 4 * hi;
    float m_reg = -1e30f, l_reg = 0; f32x16 o[4] = {};
    const int sr = tid >> 4, sc = (tid & 15) * 8, vst0 = v_st(sr, sc), vst1 = v_st(32 + sr, sc), kws = KSWZ(sr, sc * 2);
    const int vb0 = (int)(uintptr_t)V_lds + v_rd_base(lane);
    const bf16_t* Kh = cur.K; const bf16_t* Vh = cur.Vp();
#define RESC(a) do { if (__any((a) < 1.f)) { if (hi == 0) al_l[r32] = (a); asm volatile("s_waitcnt lgkmcnt(0)" ::: "memory");              \
                     for (int d_ = 0; d_ < 4; ++d_) for (int r = 0; r < 16; ++r) o[d_][r] *= al_l[crow(r, hi)]; } } while (0)
#define KBASE(t) ((j_lo + (t)) * KVBLK)
#define MASKT(P0_, P1_, t) do { const int kb_ = KBASE(t); if (kb_ + KVBLK - 1 > qlo) mask_tile(P0_, P1_, qm - kb_, W); } while (0)
    f32x16 pA0, pA1, pB0, pB1; float mnA, mnB, alA, alB; bf16x8 pa0, pa1, pa2, pa3;
    SLOAD_H(Kh, Vh, KBASE(0)); VMW(); SWRITE_HK(0); __syncthreads();
    SWRITE_HV(0); SBAR();
    if (NT > 1) { SLOAD_H(Kh, Vh, KBASE(1)); }
    SBAR(); qkt<0>(pA0, pA1, K_lds, r32, hi, S.qr, bt0 + KBASE(0));
    MASKT(pA0, pA1, 0); partialSM(pA0, pA1, m_reg, mnA, alA);
    if (NT > 1) { VMW(); SWRITE_H(1); }
    __syncthreads();
#define HALF_STEP(PX0, PX1, mnX, alX, PY0, PY1, alY, t, KB, VB, SB) do {                                                      \
        SBAR(); qkt<KB>(PX0, PX1, K_lds, r32, hi, S.qr, bt0 + KBASE(t));                                                     \
        finishSM(PY0, PY1, alY, l_reg, pa0, pa1, pa2, pa3); SBAR();                                                           \
        if ((t) + 1 < NT) { SLOAD_H(Kh, Vh, KBASE((t) + 1)); SBAR(); }                                                        \
        pv_tile<VB>(o, vb0, pa0, pa1, pa2, pa3); MASKT(PX0, PX1, (t)); partialSM(PX0, PX1, m_reg, mnX, alX);                \
        __syncthreads();                                                                                                      \
        if ((t) + 1 < NT) { VMW(); SWRITE_H(SB); }                                                                            \
        RESC(alX); __syncthreads(); } while (0)
    for (int t = 1; t + 1 < NT; t += 2) {
        HALF_STEP(pB0, pB1, mnB, alB, pA0, pA1, alA, t, 1, 0, 0);
        HALF_STEP(pA0, pA1, mnA, alA, pB0, pB1, alB, t + 1, 0, 1, 1);
    }
    SBAR(); qkt<1>(pB0, pB1, K_lds, r32, hi, S.qr, bt0 + KBASE(NT - 1)); SBAR();
#pragma unroll
    for (int d0 = 0; d0 < 8; ++d0) S.qr[d0] = load8h(nxt.Qp() + (size_t)(wid * QBLK + r32) * D + d0 * 16 + hi * 8);
    SBAR();
    finishSM(pA0, pA1, alA, l_reg, pa0, pa1, pa2, pa3); SBAR();
    pv_tile<0>(o, vb0, pa0, pa1, pa2, pa3);
    MASKT(pB0, pB1, NT - 1); partialSM(pB0, pB1, m_reg, mnB, alB); __syncthreads(); RESC(alB);
    finishSM(pB0, pB1, alB, l_reg, pa0, pa1, pa2, pa3); SBAR(); pv_tile<1>(o, vb0, pa0, pa1, pa2, pa3);
    SBAR();
    if (hi == 0) li_l[r32] = l_reg; asm volatile("s_waitcnt lgkmcnt(0)" ::: "memory");
    float rli[16];
#pragma unroll
    for (int r = 0; r < 16; ++r) rli[r] = __builtin_amdgcn_rcpf(li_l[crow(r, hi)]);
    bf16_t* Ow = cur.O + (size_t)(wid * QBLK) * OST;
#pragma unroll
    for (int r = 0; r < 16; ++r) { const int orow = crow(r, hi);
#pragma unroll
        for (int d0 = 0; d0 < 4; ++d0) { const float v = o[d0][r] * rli[r];
            const float vn = __shfl_xor(v, 1);
            if ((r32 & 1) == 0) *(unsigned*)(Ow + (size_t)orow * OST + d0 * 32 + r32) = cvt_pk_bf16(v, vn); } }
    __syncthreads();
#undef RESC
#undef KBASE
#undef MASKT
#undef HALF_STEP
}
#undef ROW
#undef VMWN
#undef SLOAD_H
#undef SWRITE_HK
#undef SWRITE_HV
#undef SWRITE_H

__device__ __forceinline__ void sample_unit(int b, int h, const float* cache_k, const float* cache_v, const float* cache_lf, const float* ks_new, const float* vs_new, const float* lf_new,
                                            const bf16_t* Qs, bf16_t* MIXs, char* lds) {
    int tid_ = threadIdx.x; asm volatile("" : "+v"(tid_)); const int tid = tid_, wid = __builtin_amdgcn_readfirstlane(tid >> 6), lane = tid & 63, r32 = lane & 31, hi = lane >> 5;
    float* bias = (float*)lds;
    float* mw = (float*)(lds + 8192);
    float* lw = mw + 256;
    float* alw = lw + 256 + wid * 64;
    float* obuf = (float*)(lds + 16384);
    constexpr int NKEY = PAST + ST;
    for (int s = tid; s < 1088; s += 512) { float v = 0.f; if (s < PAST) v = cache_lf[((size_t)b * PAST + s) * NH + h]; else if (s < NKEY) v = lf_new[((size_t)b * ST + (s - PAST)) * NH + h]; bias[s] = v; }
    __syncthreads();
    if (wid == 0) { float carry = 0.f;
        for (int ch = 0; ch < 17; ++ch) { float v = bias[ch * 64 + lane];
#pragma unroll
            for (int o = 1; o < 64; o <<= 1) { const float t = __shfl_up(v, o); if (lane >= o) v += t; }
            v += carry; carry = __shfl(v, 63); bias[ch * 64 + lane] = v; } }
    __syncthreads();
    const float cref = bias[PAST];
    __syncthreads();
    for (int s = tid; s < 1088; s += 512) bias[s] = (cref - bias[s]) * INV_SCALE;
    __syncthreads();
    bf16x8 qr[8];
#pragma unroll
    for (int d0 = 0; d0 < 8; ++d0) qr[d0] = load8h(Qs + ((size_t)(b * NH + h) * ST + r32) * D + d0 * 16 + hi * 8);
    float m_reg = -1e30f, l_reg = 0.f; f32x16 o[4] = {};
    const int ntile = (wid == 0) ? 3 : 2;
    for (int ti = 0; ti < ntile; ++ti) {
        const int T = (ti < 2) ? 2 * wid + ti : 16; const bool newt = (T == 16);
        const float* Kb = newt ? ks_new + ((size_t)b * ST * NH + h) * D : cache_k + (((size_t)b * PAST + T * 64) * NH + h) * D;
        const float* Vb = newt ? vs_new + ((size_t)b * ST * NH + h) * D : cache_v + (((size_t)b * PAST + T * 64) * NH + h) * D;
        f32x16 p0, p1; bias_init(p0, p1, (lds_cf)(__attribute__((address_space(3))) char*)lds + T * 64 + 4 * hi);
#pragma unroll
        for (int d0 = 0; d0 < 8; ++d0) {
            const bf16x8 b0 = load8f(Kb + (size_t)r32 * (NH * D) + d0 * 16 + hi * 8);
            p0 = __builtin_amdgcn_mfma_f32_32x32x16_bf16(b0, qr[d0], p0, 0, 0, 0);
            if (!newt) { const bf16x8 b1 = load8f(Kb + (size_t)(32 + r32) * (NH * D) + d0 * 16 + hi * 8);
                p1 = __builtin_amdgcn_mfma_f32_32x32x16_bf16(b1, qr[d0], p1, 0, 0, 0); } }
        if (newt) { const float NEG = -__builtin_inff();
#pragma unroll
            for (int r = 0; r < 16; ++r) { if (crow(r, hi) > r32) p0[r] = NEG; p1[r] = NEG; } }
        float mn, alpha; bf16x8 pa[4];
        partialSM(p0, p1, m_reg, mn, alpha);
        if (__any(alpha < 1.f)) { if (hi == 0) alw[r32] = alpha; asm volatile("s_waitcnt lgkmcnt(0)" ::: "memory");
#pragma unroll
            for (int d_ = 0; d_ < 4; ++d_)
#pragma unroll
                for (int r = 0; r < 16; ++r) o[d_][r] *= alw[crow(r, hi)]; }
        finishSM(p0, p1, alpha, l_reg, pa[0], pa[1], pa[2], pa[3]);
        const int nks = newt ? 2 : 4;
#pragma unroll
        for (int d0 = 0; d0 < 4; ++d0)
#pragma unroll
            for (int ks = 0; ks < 4; ++ks) if (ks < nks) {
                const float* vp = Vb + (size_t)(16 * ks + 8 * hi) * (NH * D) + d0 * 32 + r32;
                f32x4 a, c;
#pragma unroll
                for (int e = 0; e < 4; ++e) { a[e] = vp[(size_t)e * (NH * D)]; c[e] = vp[(size_t)(4 + e) * (NH * D)]; }
                o[d0] = __builtin_amdgcn_mfma_f32_32x32x16_bf16(pa[ks], pack8(a, c), o[d0], 0, 0, 0); }
    }
    constexpr float C2 = 1.4426950408889634f * SCALE;
    if (hi == 0) mw[wid * 32 + r32] = m_reg;
    __syncthreads();
    float Mx = mw[r32];
#pragma unroll
    for (int w = 1; w < 8; ++w) Mx = fmaxf(Mx, mw[w * 32 + r32]);
    const float f = __builtin_amdgcn_exp2f((m_reg - Mx) * C2);
    if (hi == 0) { lw[wid * 32 + r32] = l_reg * f; alw[r32] = f; }
    asm volatile("s_waitcnt lgkmcnt(0)" ::: "memory");
#pragma unroll
    for (int d_ = 0; d_ < 4; ++d_)
#pragma unroll
        for (int r = 0; r < 16; ++r) o[d_][r] *= alw[crow(r, hi)];
    for (int w = 0; w < 8; ++w) {
        if (wid == w) {
#pragma unroll
            for (int d0 = 0; d0 < 4; ++d0)
#pragma unroll
                for (int r = 0; r < 16; ++r) { float* p = obuf + crow(r, hi) * 128 + d0 * 32 + r32; if (w == 0) *p = o[d0][r]; else *p += o[d0][r]; } }
        __syncthreads();
    }
    { const int q = tid >> 4, d8 = (tid & 15) * 8; float L = 0.f;
#pragma unroll
      for (int w = 0; w < 8; ++w) L += lw[w * 32 + q];
      const float rl = 1.0f / L; const f32x4 a = *(const f32x4*)(obuf + q * 128 + d8) * rl, c = *(const f32x4*)(obuf + q * 128 + d8 + 4) * rl;
      u32x4 wv = {cvt_pk_bf16(a[0], a[1]), cvt_pk_bf16(a[2], a[3]), cvt_pk_bf16(c[0], c[1]), cvt_pk_bf16(c[2], c[3])};
      *(u32x4*)(MIXs + ((size_t)b * ST + q) * DM + h * HD + d8) = wv; }
    __syncthreads();
}
#undef VMW
#undef SBAR
#undef KSWZ
}

#define LAS __attribute__((address_space(3)))
__device__ __forceinline__ unsigned f2bf(float f) { unsigned u = __builtin_bit_cast(unsigned, f); return (u + 0x7fffu + ((u >> 16) & 1u)) >> 16; }
__device__ __forceinline__ unsigned pk2(float lo, float hi) { return f2bf(lo) | (f2bf(hi) << 16); }
__device__ __forceinline__ float wave_sum(float v) {
#pragma unroll
    for (int o = 1; o < 64; o <<= 1) v += __shfl_xor(v, o);
    return v;
}
__device__ __forceinline__ void transpose_item(const float* Wblk, int ldw, bf16_t* WT, int K, int drow0, int k0, LAS float* scr, int lane, const float* kg = nullptr) {
    const int kr = lane >> 3, nq = lane & 7;
    f32x4 v[8];
#pragma unroll
    for (int i = 0; i < 8; ++i) { v[i] = *(const f32x4*)(Wblk + (size_t)(k0 + 8 * i + kr) * ldw + 4 * nq); if (kg) v[i] = v[i] * kg[k0 + 8 * i + kr]; }
#pragma unroll
    for (int i = 0; i < 8; ++i) { LAS float* d = scr + (8 * i + kr) * 33 + 4 * nq; d[0] = v[i][0]; d[1] = v[i][1]; d[2] = v[i][2]; d[3] = v[i][3]; }
    asm volatile("s_waitcnt lgkmcnt(0)" ::: "memory");
    const int c = lane & 7;
#pragma unroll
    for (int j = 0; j < 4; ++j) { const int n = (lane >> 3) + 8 * j; const LAS float* s = scr + (8 * c) * 33 + n;
        u32x4 o; o.x = cvt_pk_bf16(s[0 * 33], s[1 * 33]); o.y = cvt_pk_bf16(s[2 * 33], s[3 * 33]); o.z = cvt_pk_bf16(s[4 * 33], s[5 * 33]); o.w = cvt_pk_bf16(s[6 * 33], s[7 * 33]);
        *(u32x4*)(WT + (size_t)(drow0 + n) * K + k0 + 8 * c) = o; }
    asm volatile("s_waitcnt lgkmcnt(0)" ::: "memory");
}

#define XB_TMO      128
#define XB_XCNT(j)  (256  + 64 * (j))
#define XB_XSUB(j)  (1280 + 64 * (j))
#define XB_XGEN(j)  (2304 + 64 * (j))
#define XB_TOP      3328
#define XB_TOPGEN   3392
#define XCD_BAR_WORDS 3456
#define XB_SPIN_CAP (1u << 22)
__device__ __forceinline__ unsigned xb_ld(unsigned* p)              { return __hip_atomic_load(p, __ATOMIC_RELAXED, __HIP_MEMORY_SCOPE_AGENT); }
__device__ __forceinline__ unsigned xb_add(unsigned* p, unsigned v) { return __hip_atomic_fetch_add(p, v, __ATOMIC_RELAXED, __HIP_MEMORY_SCOPE_AGENT); }
__device__ __forceinline__ unsigned xb_xcc_id() { return (unsigned)__builtin_amdgcn_s_getreg((3 << 11) | 20) & 0xFu; }
#define XB_SPIN(cond, bar) do { unsigned _sp = 0; while (cond) { __builtin_amdgcn_s_sleep(1); \
    if ((++_sp & 255u) == 0u) { if (xb_ld(&(bar)[XB_TMO])) break; if (_sp > XB_SPIN_CAP) { atomicAdd(&(bar)[XB_TMO], 1u); break; } } } } while (0)
__device__ __forceinline__ void xcd_barrier_complete(unsigned* bar, unsigned x, unsigned& nloc, unsigned& nx) {
    const unsigned G = gridDim.x * gridDim.y * gridDim.z;
    unsigned sum, cnt, mine, sp = 0u;
    for (;;) {
        sum = 0u; cnt = 0u; mine = 0u;
#pragma unroll
        for (unsigned j = 0; j < 16; ++j) { const unsigned c = xb_ld(&bar[XB_XCNT(j)]); sum += c; cnt += (c > 0u) ? 1u : 0u; mine = (j == x) ? c : mine; }
        if (sum == G) break;
        __builtin_amdgcn_s_sleep(1);
        if ((++sp & 255u) == 0u) { if (xb_ld(&bar[XB_TMO])) break; if (sp > XB_SPIN_CAP) { atomicAdd(&bar[XB_TMO], 1u); break; } }
    }
    nloc = mine > 0u ? mine : 1u; nx = cnt > 0u ? cnt : 1u;
}
__device__ __forceinline__ void xcd_barrier(unsigned* bar, volatile __attribute__((address_space(3))) unsigned* st) {
    asm volatile("s_waitcnt vmcnt(0)" ::: "memory");
    __syncthreads();
    if (threadIdx.x == 0) {
        const unsigned x = xb_xcc_id();
        __builtin_amdgcn_s_waitcnt(0);
        unsigned nloc = st[0], nx = st[1];
        if (nloc == 0u) { xcd_barrier_complete(bar, x, nloc, nx); st[0] = nloc; st[1] = nx; }
        const unsigned old = xb_add(&bar[XB_XSUB(x)], 1u);
        const unsigned gen = old / nloc;
        if (old + 1u == (gen + 1u) * nloc) {
            __builtin_amdgcn_fence(__ATOMIC_RELEASE, "agent");
            asm volatile("s_waitcnt vmcnt(0)" ::: "memory");
            const unsigned og = xb_add(&bar[XB_TOP], 1u);
            const unsigned tg = og / nx;
            if (og + 1u == (tg + 1u) * nx) xb_add(&bar[XB_TOPGEN], 1u);
            else XB_SPIN(xb_ld(&bar[XB_TOPGEN]) == tg, bar);
            __builtin_amdgcn_fence(__ATOMIC_ACQUIRE, "agent");
            xb_add(&bar[XB_XGEN(x)], 1u);
            asm volatile("s_waitcnt vmcnt(0)" ::: "memory");
        } else {
            XB_SPIN(xb_ld(&bar[XB_XGEN(x)]) == gen, bar);
            __builtin_amdgcn_fence(__ATOMIC_ACQUIRE, "agent");
            asm volatile("s_waitcnt vmcnt(0)" ::: "memory");
        }
    }
    __syncthreads();
}

__device__ __forceinline__ const __attribute__((address_space(4))) Args* kargs() { unsigned long long p = (unsigned long long)__builtin_amdgcn_kernarg_segment_ptr(); asm volatile("" : "+s"(p)); return (const __attribute__((address_space(4))) Args*)p; }
__global__ void __launch_bounds__(512, 2) fox_fwd(Args args) {
    extern __shared__ __attribute__((aligned(16))) unsigned char lds[];
    cg::grid_group grid = cg::this_grid();
    const int G = gridDim.x, bx = blockIdx.x;
    constexpr int LDS_BARST = 131072 + 512;
    if (threadIdx.x < 64) ((LAS unsigned*)((PG8_LAS unsigned char*)lds + 131072))[threadIdx.x] = 0u;
    if (threadIdx.x < 2) ((LAS unsigned*)((PG8_LAS unsigned char*)lds + LDS_BARST))[threadIdx.x] = 0u;
    __syncthreads();
    if (threadIdx.x == 0 && args.ph_hi - args.ph_lo > 1) { unsigned* bar_ = (unsigned*)args.ws; (void)xb_add(&bar_[XB_XCNT(xb_xcc_id())], 1u); }
#define TIDS int tid = threadIdx.x; asm volatile("" : "+v"(tid)); const int lane = tid & 63, wave = __builtin_amdgcn_readfirstlane(tid >> 6); (void)lane; (void)wave;
#define PTRS \
    const __attribute__((address_space(4))) Args* A_ = kargs(); unsigned char* ws = A_->ws; float* out = A_->out; (void)ws; (void)out; \
    const float* x_prompt = A_->in[0]; const float* x_sample = A_->in[1]; (void)x_prompt; (void)x_sample; \
    float* rowss1 = (float*)(ws + WS_ROWSS); float* rowss2 = rowss1 + 65536; float* rowss3 = rowss2 + 65536; (void)rowss1; (void)rowss2; (void)rowss3; \
    bf16_t* Wgu1 = (bf16_t*)(ws + WS_WGU1); bf16_t* Wd1 = (bf16_t*)(ws + WS_WD1); bf16_t* Win = (bf16_t*)(ws + WS_WIN); bf16_t* Wo = (bf16_t*)(ws + WS_WO); \
    bf16_t* Wgu2 = (bf16_t*)(ws + WS_WGU2); bf16_t* Wd2 = (bf16_t*)(ws + WS_WD2); bf16_t* Wpool = (bf16_t*)(ws + WS_WPOOL); \
    bf16_t* ABUF = (bf16_t*)(ws + WS_ABUF); bf16_t* HB = (bf16_t*)(ws + WS_H); \
    bf16_t* Qb = (bf16_t*)(ws + WS_Q); bf16_t* Kb = (bf16_t*)(ws + WS_K); bf16_t* Vb = (bf16_t*)(ws + WS_V); float* Pb = (float*)(ws + WS_P); \
    bf16_t* Db = (bf16_t*)(ws + WS_D); bf16_t* MIX = (bf16_t*)(ws + WS_MIX); float* Cp = (float*)(ws + WS_C); float* SPL = (float*)(ws + WS_SPLIT); unsigned* SPC = (unsigned*)(ws + WS_SPLITCNT); (void)SPL; (void)SPC; \
    (void)Wgu1; (void)Wd1; (void)Win; (void)Wo; (void)Wgu2; (void)Wd2; (void)Wpool; (void)ABUF; (void)HB; (void)Qb; (void)Kb; (void)Vb; (void)Pb; (void)Db; (void)MIX; (void)Cp;
    PG8_LAS unsigned char* lds3 = (PG8_LAS unsigned char*)lds;
    const int lo = args.ph_lo, hi_ph = args.ph_hi;
#ifndef PH_MASK
#define PH_MASK 0x3ff
#endif
#define IN(k) (((PH_MASK >> (k)) & 1) && lo <= (k) && (k) < hi_ph)
#define SEAM(k) do { if (IN(k) && IN((k) + 1)) { unsigned* bar_ = (unsigned*)kargs()->ws; xcd_barrier(bar_, (volatile LAS unsigned*)((PG8_LAS unsigned char*)lds + LDS_BARST)); } } while (0)
    if (args.ph_hi - args.ph_lo > 1) grid.sync();

    if (IN(0)) { PTRS TIDS
        LAS float* scr = (LAS float*)(lds3 + wave * 16384);
        const int gw = bx * 8 + wave, NGW = G * 8;
        constexpr int I_GU = (DM / 64) * (DFF / 32), I_DN = (DFF / 64) * (DM / 32), I_INA = (DM / 64) * (3 * FOXW / 32), I_INP = (DM / 64) * (POOLW / 32), I_O = (DM / 64) * (DM / 32), I_PL = 4 * (256 / 64) * (256 / 32);
        constexpr int NITEMS = 4 * I_GU + 2 * I_DN + I_INA + I_INP + I_O + I_PL;
        for (int it = gw; it < NITEMS; it += NGW) {
            int r = it;
            if (r < 4 * I_GU) {
                const int which = r / I_GU; r -= which * I_GU; const int nblk = DFF / 32, kb = r / nblk, nb = r % nblk, n0 = 32 * nb;
                const float* W = A_->in[which == 0 ? 7 : which == 1 ? 8 : which == 2 ? 17 : 18];
                bf16_t* WT = which < 2 ? Wgu1 : Wgu2; const int drow = (n0 >> 7) * 256 + (which & 1) * 128 + (n0 & 127);
                transpose_item(W + n0, DFF, WT, DM, drow, 64 * kb, scr, lane, which < 2 ? nullptr : A_->in[16]); continue; }
            r -= 4 * I_GU;
            if (r < 2 * I_DN) { const int which = r / I_DN; r -= which * I_DN; const int nblk = DM / 32, kb = r / nblk, nb = r % nblk;
                transpose_item(A_->in[which == 0 ? 9 : 19] + 32 * nb, DM, which == 0 ? Wd1 : Wd2, DFF, 32 * nb, 64 * kb, scr, lane); continue; }
            r -= 2 * I_DN;
            if (r < I_INA) { const int nblk = 3 * FOXW / 32, kb = r / nblk, nb = r % nblk; transpose_item(A_->in[11] + 32 * nb, INW, Win, DM, 32 * nb, 64 * kb, scr, lane, A_->in[10]); continue; }
            r -= I_INA;
            if (r < I_INP) { const int nblk = POOLW / 32, kb = r / nblk, nb = r % nblk; transpose_item(A_->in[11] + 3 * FOXW + NH + 32 * nb, INW, Win, DM, 3 * FOXW + 32 * nb, 64 * kb, scr, lane, A_->in[10]); continue; }
            r -= I_INP;
            if (r < I_O) { const int nblk = DM / 32, kb = r / nblk, nb = r % nblk;
                if (kb < 16) transpose_item(A_->in[15] + 32 * nb, DM, Wo, DM, 32 * nb, 64 * kb, scr, lane);
                else transpose_item(A_->in[15] + (size_t)FOXW * DM + 32 * nb, DM, (bf16_t*)(ws + WS_D), FOXW, 32 * nb, 64 * kb - FOXW, scr, lane);
                continue; }
            r -= I_O;
            { }
        }
        for (int i = bx * 512 + tid; i < NH * DM; i += G * 512) { const int j = i / DM, k = i % DM; Win[(size_t)(4 * FOXW + j) * DM + k] = (bf16_t)f2bf(A_->in[11][(size_t)k * INW + 3 * FOXW + j] * A_->in[10][k]); }
        for (int i = bx * 512 + tid; i < (INWP - 4 * FOXW - NH) * DM / 8; i += G * 512) *(u32x4*)(Win + (size_t)(4 * FOXW + NH) * DM + (size_t)i * 8) = (u32x4){0u, 0u, 0u, 0u};
        for (int i = bx * 512 + tid; i < 3 * 65536; i += G * 512) rowss1[i] = 0.f;
        for (int i = bx * 512 + tid; i < 4 * 65536; i += G * 512) Wpool[i] = (bf16_t)f2bf(A_->in[13][i] * A_->in[14][((i >> 16) << 8) + (i & 255)]);
        for (int i = bx * 512 + tid; i < MP * NH; i += G * 512) { ((float*)(ws + WS_NQ2))[i] = 0.f; ((float*)(ws + WS_NK2))[i] = 0.f; }
        const float* g1 = A_->in[6];
        for (int m = gw; m < MTOT; m += NGW) {
            const f32x4* xr = (const f32x4*)(m < MP ? x_prompt + (size_t)m * DM : x_sample + (size_t)(m - MP) * DM) + lane;
            f32x4 v[8]; float s = 0.f;
#pragma unroll
            for (int j = 0; j < 8; ++j) { v[j] = xr[64 * j]; s += (v[j][0] * v[j][0] + v[j][1] * v[j][1]) + (v[j][2] * v[j][2] + v[j][3] * v[j][3]); }
            const float rstd = 1.0f / sqrtf(wave_sum(s) * (1.0f / DM) + EPS);
            u32x2* o8 = (u32x2*)(ABUF + (size_t)m * DM) + lane;
#pragma unroll
            for (int j = 0; j < 8; ++j) { const f32x4 gg = ((const f32x4*)g1)[lane + 64 * j]; const f32x4 y = v[j] * rstd * gg; o8[64 * j] = (u32x2){cvt_pk_bf16(y[0], y[1]), cvt_pk_bf16(y[2], y[3])}; }
        }
    }
    SEAM(0);
    if (IN(1)) { PTRS TIDS pg8::Gemm g{ABUF, Wgu1, MTOT, 2 * DFF, DM, DM, 0}; pg8::StaticOrder S; S.init(MTOT, 2 * DFF, DM, G, bx, 0, nullptr, nullptr);
        pg8::EpiGU E{HB, nullptr}; pg8::gemm_phase(lds3, g, S, E); }
    SEAM(1);
    if (IN(2)) { PTRS TIDS pg8::Gemm g{HB, Wd1, MTOT, DM, DFF, DFF, 0}; pg8::StaticOrder S; S.init(MTOT, DM, DFF, G, bx, 0, SPL, SPC);
        pg8::EpiRes E{x_prompt, x_sample, nullptr, 0.5f, ABUF, rowss1}; pg8::gemm_phase(lds3, g, S, E); }
    SEAM(2);
    if (IN(3)) { PTRS TIDS pg8::Gemm g{ABUF, Win, MTOT, INWP, DM, DM, 0}; pg8::StaticOrder S; S.init(MTOT, INWP, DM, G, bx, 0, nullptr, nullptr);
        pg8::EpiIn E{rowss1, out, Qb, Kb, Vb, Pb, A_->in[12], (float*)(ws + WS_NQ2), (float*)(ws + WS_NK2)}; pg8::gemm_phase(lds3, g, S, E); }
    SEAM(3);
    if (IN(4)) { PTRS TIDS
        { pg8::Gemm g{(bf16_t*)(ws + WS_D), Wpool, DM, POOLW, 256, POOLW, 256}; pg8::StaticOrder S; S.init(DM, POOLW, 256, G, bx, 0, nullptr, nullptr);
          pg8::EpiFold E{Wo}; pg8::gemm_phase(lds3, g, S, E); __syncthreads(); }
        if (bx >= G - 32 && wave == 0) {
            const int bh = bx - (G - 32), b = bh >> 3, h = bh & 7; const float* lf = out + O_LFP + (size_t)b * SEQ * NH + h; float* c = Cp + (size_t)bh * SEQ; float carry = 0.f;
            const float* nq = (const float*)(ws + WS_NQ2) + (size_t)b * SEQ * NH + h; const float* nk = (const float*)(ws + WS_NK2) + (size_t)b * SEQ * NH + h;
            float* QN = (float*)(ws + WS_QN) + bh * 32; float* KN = (float*)(ws + WS_KN) + bh; float qmax = 0.f, kmax = 0.f;
            for (int ch = 0; ch < SEQ / 64; ++ch) { float v = lf[(size_t)(ch * 64 + lane) * NH];
                qmax = fmaxf(qmax, ld_agent(nq + (size_t)(ch * 64 + lane) * NH)); kmax = fmaxf(kmax, ld_agent(nk + (size_t)(ch * 64 + lane) * NH));
#pragma unroll
                for (int o = 1; o < 64; o <<= 1) { const float t = __shfl_up(v, o); if (lane >= o) v += t; }
                v += carry; carry = __shfl(v, 63); c[ch * 64 + lane] = v;
                if ((ch & 3) == 3) {
#pragma unroll
                    for (int o = 1; o < 64; o <<= 1) qmax = fmaxf(qmax, __shfl_xor(qmax, o));
                    if (lane == 0) QN[ch >> 2] = qmax; qmax = 0.f; } }
#pragma unroll
            for (int o = 1; o < 64; o <<= 1) kmax = fmaxf(kmax, __shfl_xor(kmax, o));
            if (lane == 0) *KN = kmax;
        }
        const float* sp = A_->in[5];
        for (int item = bx; item < MTOT / 64; item += G) {
            const int m0 = (item * 2 + (tid >> 8)) * 32, col = (tid & 255) * 4, w = 2 << (col >> 8);
            const bool samp = m0 >= MP; const int t0 = samp ? 0 : (m0 & (SEQ - 1)); const int sb = samp ? (m0 - MP) >> 5 : 0;
            const float* hist = sp + (size_t)sb * PHIST * POOLW + col;
            const float* P = Pb + (size_t)m0 * POOLW + col;
            f32x4 s = {0.f, 0.f, 0.f, 0.f};
            for (int j = 1; j < w; ++j) { f32x4 v = {0.f, 0.f, 0.f, 0.f};
                if (samp) v = *(const f32x4*)(hist + (size_t)(PHIST - j) * POOLW); else if (t0 - j >= 0) v = *(const f32x4*)(P - (size_t)j * POOLW);
                s += v; }
            for (int i0 = 0; i0 < 32; i0 += 8) {
                f32x4 curv[8], oldv[8];
#pragma unroll
                for (int e = 0; e < 8; ++e) { const int i = i0 + e, io = i - (w - 1); curv[e] = *(const f32x4*)(P + (size_t)i * POOLW); f32x4 old = {0.f, 0.f, 0.f, 0.f};
                    if (io >= 0) old = *(const f32x4*)(P + (size_t)io * POOLW);
                    else { const int j = -io; if (samp) old = *(const f32x4*)(hist + (size_t)(PHIST - j) * POOLW); else if (t0 - j >= 0) old = *(const f32x4*)(P - (size_t)j * POOLW); }
                    oldv[e] = old; }
#pragma unroll
                for (int e = 0; e < 8; ++e) { const int i = i0 + e; const f32x4 cur = curv[e]; s += cur;
                    const int cnt = samp ? w : ((t0 + i + 1) < w ? (t0 + i + 1) : w);
                    const f32x4 d = s * (1.0f / (float)cnt) - cur;
                    *(u32x2*)(MIX + (size_t)(m0 + i) * DM + FOXW + col) = (u32x2){cvt_pk_bf16(d[0], d[1]), cvt_pk_bf16(d[2], d[3])};
                    s -= oldv[e];
                    if (!samp) { const int t = t0 + i; if (t >= SEQ - PHIST) *(f32x4*)(out + O_PP + ((size_t)(m0 >> 13) * PHIST + (t - (SEQ - PHIST))) * POOLW + col) = cur; }
                    else if (i >= ST - PHIST) *(f32x4*)(out + O_PS + ((size_t)sb * PHIST + (i - (ST - PHIST))) * POOLW + col) = cur; }
            }
        }
    }
    SEAM(4);
    if (IN(5)) { PTRS TIDS
#ifndef P5_PARTS
#define P5_PARTS 7
#endif
        if (P5_PARTS & 1) {
            fox::Seam S; unsigned* qctr = (unsigned*)(ws + WS_QUEUE); const float* QN = (const float*)(ws + WS_QN); const float* KN = (const float*)(ws + WS_KN);
            int* nl = (int*)((char*)lds + fox::LDS_BIAS - 32);
            auto mkref = [&](int n) { const int bh = n & 31, qb = 31 - (n >> 5), b = bh >> 3, h = bh & 7;
                fox::BlockRef r; r.K = Kb + (size_t)bh * SEQ * HD; r.O = MIX + ((size_t)b * SEQ + (size_t)qb * 256) * DM + h * HD; r.C = Cp + (size_t)bh * SEQ; r.P0 = qb * 256;
                r.nrm = 1.02f * fox::SCALE * sqrtf(QN[bh * 32 + qb] * KN[bh]); return r; };
#define GRAB(dst) do { if (tid == 0) *nl = (int)__hip_atomic_fetch_add(qctr, 1u, __ATOMIC_RELAXED, __HIP_MEMORY_SCOPE_AGENT); __syncthreads(); dst = __builtin_amdgcn_readfirstlane(*nl); __syncthreads(); } while (0)
            int n; GRAB(n);
            if (n < NB * NH * 32) {
                fox::BlockRef cur = mkref(n);
                fox::prime(cur, (char*)lds, S);
                for (;;) {
                    int nn; GRAB(nn); const bool last = nn >= NB * NH * 32;
                    const fox::BlockRef nxt = last ? cur : mkref(nn);
                    fox::block(cur, nxt, (char*)lds, S);
                    if (last) break;
                    cur = nxt;
                }
            }
#undef GRAB
            asm volatile("s_waitcnt vmcnt(0)" ::: "memory"); __syncthreads();
        }
        if (P5_PARTS & 2) for (;;) { int* nl2 = (int*)((char*)lds + 65536); unsigned* sctr = (unsigned*)(ws + WS_QUEUE) + 16;
            __syncthreads(); if (tid == 0) *nl2 = (int)__hip_atomic_fetch_add(sctr, 1u, __ATOMIC_RELAXED, __HIP_MEMORY_SCOPE_AGENT); __syncthreads(); const int u = __builtin_amdgcn_readfirstlane(*nl2); __syncthreads(); if (u >= SBATCH * NH) break;
            const int b = u >> 3, h = u & 7;
            fox::sample_unit(b, h, A_->in[2], A_->in[3], A_->in[4], out + O_KS, out + O_VS, out + O_LFS, Qb + (size_t)MP * FOXW, MIX + (size_t)MP * DM, (char*)lds);
        }
        __syncthreads();
    }
    SEAM(5);
    if (IN(6)) { PTRS TIDS pg8::Gemm g{MIX, Wo, MTOT, DM, DM, DM, 0}; pg8::StaticOrder S; S.init(MTOT, DM, DM, G, bx, 16, SPL, SPC);
        pg8::EpiRes E{nullptr, nullptr, ABUF, 1.0f, ABUF, rowss2}; pg8::gemm_phase(lds3, g, S, E); }
    SEAM(6);
    if (IN(7)) { PTRS TIDS pg8::Gemm g{ABUF, Wgu2, MTOT, 2 * DFF, DM, DM, 0}; pg8::StaticOrder S; S.init(MTOT, 2 * DFF, DM, G, bx, 0, nullptr, nullptr);
        pg8::EpiGU E{HB, rowss2}; pg8::gemm_phase(lds3, g, S, E); }
    SEAM(7);
    if (IN(8)) { PTRS TIDS pg8::Gemm g{HB, Wd2, MTOT, DM, DFF, DFF, 0}; pg8::StaticOrder S; S.init(MTOT, DM, DFF, G, bx, 32, SPL, SPC);
        pg8::EpiRes E{nullptr, nullptr, ABUF, 0.5f, ABUF, rowss3};   pg8::gemm_phase(lds3, g, S, E); }
    SEAM(8);
    if (IN(9)) { PTRS TIDS
        const float* gf = A_->in[20]; const int gw = bx * 8 + wave, NGW = G * 8;
        for (int m = gw; m < MTOT; m += 2 * NGW) { const int m2 = m + NGW; const bool two = m2 < MTOT; const int mb = two ? m2 : m;
            const u32x2* pa = (const u32x2*)(ABUF + (size_t)m * DM) + lane; const u32x2* pb = (const u32x2*)(ABUF + (size_t)mb * DM) + lane;
            f32x4* ya = (f32x4*)(out + O_Y + (size_t)m * DM) + lane; f32x4* yb = (f32x4*)(out + O_Y + (size_t)mb * DM) + lane;
            const float ra = rstd_of(rowss3, m), rb = rstd_of(rowss3, mb);
            u32x2 va[8], vb[8];
#pragma unroll
            for (int j = 0; j < 8; ++j) { va[j] = pa[64 * j]; vb[j] = pb[64 * j]; }
#pragma unroll
            for (int j = 0; j < 8; ++j) { const f32x4 gg = ((const f32x4*)gf)[lane + 64 * j];
                const f32x4 xa = {__uint_as_float(va[j].x << 16), __uint_as_float(va[j].x & 0xffff0000u), __uint_as_float(va[j].y << 16), __uint_as_float(va[j].y & 0xffff0000u)};
                const f32x4 xb = {__uint_as_float(vb[j].x << 16), __uint_as_float(vb[j].x & 0xffff0000u), __uint_as_float(vb[j].y << 16), __uint_as_float(vb[j].y & 0xffff0000u)};
                ya[64 * j] = xa * ra * gg; if (two) yb[64 * j] = xb * rb * gg; } }
    }
#undef IN
#undef SEAM
}

#ifndef MK_SPLIT
#define MK_SPLIT 0
#endif
extern "C" void kernel_launch(void* const* d_in, const int* in_sizes, int n_in, void* d_out, int out_size, void* d_ws, size_t ws_size, hipStream_t stream) {
    static int grid = 0;
    if (grid == 0) {
        if (n_in != 21 || (size_t)out_size != O_END || ws_size < WS_END) { fprintf(stderr, "kernel_launch: unexpected shapes (n_in %d out %d ws %zu)\n", n_in, out_size, ws_size); grid = -1; return; }
        int dev = 0, cus = 0, per_cu = 0;
        (void)hipGetDevice(&dev); (void)hipDeviceGetAttribute(&cus, hipDeviceAttributeMultiprocessorCount, dev);
        if (hipFuncSetAttribute((const void*)fox_fwd, hipFuncAttributeMaxDynamicSharedMemorySize, LDS_BYTES) != hipSuccess) { fprintf(stderr, "hipFuncSetAttribute failed\n"); grid = -1; return; }
        if (hipOccupancyMaxActiveBlocksPerMultiprocessor(&per_cu, (const void*)fox_fwd, 512, LDS_BYTES) != hipSuccess || per_cu < 1) per_cu = 1;
        (void)hipGetLastError();
        grid = cus * per_cu;
        fprintf(stderr, "fox_fwd: cus %d per_cu %d grid %d\n", cus, per_cu, grid);
    }
    if (grid < 0) return;
    if (hipMemsetAsync(d_ws, 0, 65536, stream) != hipSuccess) { fprintf(stderr, "memset failed\n"); return; }
    Args a{};
    for (int i = 0; i < 21; ++i) a.in[i] = (const float*)d_in[i];
    a.out = (float*)d_out; a.ws = (unsigned char*)d_ws;
#if MK_SPLIT
    for (int p = 0; p < 10; ++p) { a.ph_lo = p; a.ph_hi = p + 1; hipLaunchKernelGGL(fox_fwd, dim3(grid), dim3(512), LDS_BYTES, stream, a); }
#else
    a.ph_lo = 0; a.ph_hi = 10;
    void* kargs[] = {&a};
    hipError_t e = hipLaunchCooperativeKernel((const void*)fox_fwd, dim3(grid), dim3(512), kargs, LDS_BYTES, stream);
    if (e != hipSuccess) fprintf(stderr, "cooperative launch failed: %s (grid %d)\n", hipGetErrorString(e), grid);
#endif
}
```

```cpp
#include <hip/hip_runtime.h>
#include <hip/hip_bf16.h>
#include <hip/hip_cooperative_groups.h>
#include <cstdio>
#include <cstdint>
#include <cmath>
namespace cg = cooperative_groups;

constexpr int DM = 2048, SEQ = 8192, NB = 4, MP = NB * SEQ, SBATCH = 16, ST = 32, MS = SBATCH * ST, MTOT = MP + MS, PAST = 1024;
constexpr int NH = 8, HD = 128, FOXW = 1024, POOLW = 1024, DFF = 5632, INW = 4104, INWP = 4352, PHIST = 15;
constexpr float EPS = 1e-6f;
constexpr size_t O_Y = 0, O_KP = 68157440, O_VP = 101711872, O_LFP = 135266304, O_PP = 135528448, O_KS = 135589888, O_VS = 136114176, O_LFS = 136638464, O_PS = 136642560, O_END = 136888320;
constexpr size_t MiB = 1u << 20;
constexpr size_t WS_ROWSS = 1 * MiB;
constexpr size_t WS_WGU1 = 2 * MiB, WS_WD1 = 46 * MiB, WS_WIN = 68 * MiB, WS_WO = 85 * MiB, WS_WGU2 = 93 * MiB, WS_WD2 = 137 * MiB, WS_WPOOL = 159 * MiB;
constexpr size_t WS_ABUF = 160 * MiB;
constexpr size_t WS_H = 290 * MiB;
constexpr size_t WS_Q = 290 * MiB, WS_K = 355 * MiB, WS_V = 420 * MiB, WS_P = 485 * MiB;
constexpr size_t WS_D = 648 * MiB, WS_MIX = 713 * MiB, WS_C = 843 * MiB, WS_SPLIT = 848 * MiB, WS_END = 904 * MiB;
constexpr size_t WS_NQ2 = 844 * MiB, WS_NK2 = 846 * MiB;
constexpr size_t WS_QUEUE = 20480, WS_QN = 24576, WS_KN = 32768;
constexpr size_t WS_SPLITCNT = 16384;
constexpr int N_SPLIT_SLOTS = 224;

constexpr int LDS_BYTES = 147456;

typedef unsigned short bf16_t;
typedef short bf16x8 __attribute__((ext_vector_type(8)));
typedef short s16x4 __attribute__((ext_vector_type(4)));
typedef float f32x4 __attribute__((ext_vector_type(4)));
typedef float f32x16 __attribute__((ext_vector_type(16)));
typedef unsigned u32x4 __attribute__((ext_vector_type(4)));
typedef unsigned u32x2 __attribute__((ext_vector_type(2)));

struct Args {
    const float* in[21];
    float* out; unsigned char* ws;
    int ph_lo, ph_hi;
};

__device__ __forceinline__ unsigned cvt_pk_bf16(float lo, float hi) { unsigned r; asm volatile("v_cvt_pk_bf16_f32 %0, %1, %2" : "=v"(r) : "v"(lo), "v"(hi)); return r; }
__device__ __forceinline__ float ld_agent(const float* p) { return __hip_atomic_load(p, __ATOMIC_RELAXED, __HIP_MEMORY_SCOPE_AGENT); }
__device__ __forceinline__ float rstd_of(const float* rowss, int row) { return 1.0f / sqrtf(ld_agent(rowss + row) * (1.0f / DM) + EPS); }

namespace pg8 {
#define PG8_LAS __attribute__((address_space(3)))
constexpr int BM = 256, BK = 64, HALF = 128, HTB = HALF * BK * 2, STAGE_BYTES = 8 * HTB, NXCD = 8, WGM = 8;
__host__ __device__ __forceinline__ int lds_byte(int r, int c) { const int st = (r >> 4) * 2 + (c >> 5), rr = r & 15, cc = c & 31, ob = rr * 64 + cc * 2; return st * 1024 + (ob ^ (((ob >> 9) & 1) << 5)); }
__host__ __device__ __forceinline__ void stage_rc(int b, int& R, int& C) { const int st = b / 1024, sb = b % 1024, swz = sb ^ (((sb >> 9) & 1) << 5); R = (st >> 1) * 16 + swz / 64; C = (st & 1) * 32 + (swz % 64) / 2; }
__host__ __device__ __forceinline__ int perm32(int rho) { const int n = rho >> 4, i = rho & 15; return 8 * (i >> 2) + 4 * n + (i & 3); }
struct Unit { int pm, pn, k0, nk, slot; };
struct Gemm { const bf16_t* A; const bf16_t* Bt; int M, N, K, lda, apn; };
struct StaticOrder {
    int nM, nN, nwg, G, c, ntk, nfull, R, SK, slot0, wgm; float* scratch; unsigned* cnt;
    __host__ __device__ __forceinline__ void init(int M, int N, int K, int G_, int c_, int slot0_, float* scratch_, unsigned* cnt_) { nM = M / BM; nN = N / BM; nwg = nM * nN; G = G_; c = c_; ntk = K / BK; slot0 = slot0_; scratch = scratch_; cnt = cnt_; wgm = (nN == 8) ? 4 : WGM;
        nfull = (nwg / G) * G; R = nwg - nfull; SK = 1;
        if (R > 0 && scratch_) { while (SK < 4 && R * SK * 2 <= G && (ntk / (SK * 2)) % 2 == 0 && ntk / (SK * 2) >= 4) SK *= 2; } }
    __host__ __device__ __forceinline__ void map(int L, Unit& u) const {
        int wgid = L; { const int q = nwg / NXCD, r = nwg % NXCD, xcd = wgid % NXCD, off = wgid / NXCD; wgid = (xcd < r ? xcd * (q + 1) : r * (q + 1) + (xcd - r) * q) + off; }
        const int nig = wgm * nN, gid = wgid / nig, fm = gid * wgm, gsz = (nM - fm) < wgm ? (nM - fm) : wgm;
        u.pm = fm + ((wgid % nig) % gsz); u.pn = (wgid % nig) / gsz; }
    __host__ __device__ __forceinline__ bool next(int i, Unit& u) const {
        const int rf = nfull / G;
        if (i < rf) { map(i * G + c, u); u.k0 = 0; u.nk = ntk; u.slot = -1; return true; }
        if (i > rf) return false;
        if (SK == 1) { const int L = nfull + c; if (L >= nwg) return false; map(L, u); u.k0 = 0; u.nk = ntk; u.slot = -1; return true; }
        if (c >= R * SK) return false;
        const int ui = c / SK, part = c % SK; map(nfull + ui, u); u.nk = ntk / SK; u.k0 = part * u.nk; u.slot = slot0 + ui; return true;
    }
};
template <class Epi> __device__ __forceinline__ void epi_all(const Epi& E, const f32x4 (&acc)[2][2][4][2], const Unit& u, int wr, int wc, int fr, int fq, const float (&rsq)[8]);
template <class Epi>
__device__ __forceinline__ void gemm_phase(PG8_LAS unsigned char* lds, const Gemm g, const StaticOrder& S, const Epi& E) {
    int tid_ = threadIdx.x; asm volatile("" : "+v"(tid_)); const int tid = tid_, wid = __builtin_amdgcn_readfirstlane(tid >> 6), lane = tid & 63, wr = wid >> 2, wc = wid & 3, fr = lane & 15, fq = lane >> 4;
    const int K = g.K;
    unsigned voffA[2], voffB[2];
#pragma unroll
    for (int i = 0; i < 2; ++i) { int R, C; stage_rc(tid * 16 + i * 8192, R, C); const int Rb = (R & ~31) + perm32(R & 31);
        voffA[i] = (unsigned)(R * g.lda + C) * 2u; voffB[i] = (unsigned)(Rb * K + C) * 2u; }
    const size_t kstep = (size_t)(BK * 2);
    const size_t hstepA = (size_t)HALF * g.lda * 2, hstepB = (size_t)HALF * K * 2;
    const size_t tstepA = 2 * hstepA, tstepB = 2 * hstepB;
    const unsigned ldsw = (unsigned)wid * 1024u;
    const int aoff = lds_byte(wr * 64 + fr, fq * 8), boff = lds_byte(wc * 32 + fr, fq * 8);
#define PG8_SA(b, h) (((b) * 2 + (h)) * HTB)
#define PG8_SB(b, h) ((4 + (b) * 2 + (h)) * HTB)
#define PG8_STAGE(bufoff, gbase, voff) do { _Pragma("unroll") for (int _i = 0; _i < 2; ++_i) \
        __builtin_amdgcn_global_load_lds((const unsigned*)((const char*)(gbase) + (voff)[_i]), (PG8_LAS unsigned*)(lds + (bufoff) + ldsw + _i * 8192), 16, 0, 0); } while (0)
#define PG8_LDA(dst, b, h) do { _Pragma("unroll") for (int m = 0; m < 4; ++m) _Pragma("unroll") for (int k = 0; k < 2; ++k) dst[m][k] = *(const PG8_LAS bf16x8*)(lds + PG8_SA(b, h) + aoff + m * 2048 + k * 1024); } while (0)
#define PG8_LDB(dst, b, h) do { _Pragma("unroll") for (int n = 0; n < 2; ++n) _Pragma("unroll") for (int k = 0; k < 2; ++k) dst[n][k] = *(const PG8_LAS bf16x8*)(lds + PG8_SB(b, h) + boff + n * 2048 + k * 1024); } while (0)
#define PG8_MMA(ai, bj, At, Bt) do { __builtin_amdgcn_s_setprio(1); _Pragma("unroll") for (int m = 0; m < 4; ++m) _Pragma("unroll") for (int n = 0; n < 2; ++n) _Pragma("unroll") for (int k = 0; k < 2; ++k) \
        acc[ai][bj][m][n] = __builtin_amdgcn_mfma_f32_16x16x32_bf16(Bt[n][k], At[m][k], acc[ai][bj][m][n], 0, 0, 0); __builtin_amdgcn_s_setprio(0); } while (0)
#define PG8_WAIT_V(n) asm volatile("s_waitcnt vmcnt(" #n ")" ::: "memory")
#define PG8_WAIT_L(n) asm volatile("s_waitcnt lgkmcnt(" #n ")" ::: "memory")
#define PG8_BAR __builtin_amdgcn_s_barrier()
#define PG8_SCHED __builtin_amdgcn_sched_barrier(0)
    Unit cur, nxt; int ui = 0;
    if (!S.next(0, cur)) return;
    f32x4 acc[2][2][4][2];
#pragma unroll
    for (int a = 0; a < 2; ++a)
#pragma unroll
        for (int b = 0; b < 2; ++b)
#pragma unroll
            for (int m = 0; m < 4; ++m)
#pragma unroll
                for (int n = 0; n < 2; ++n) acc[a][b][m][n] = (f32x4){0.f, 0.f, 0.f, 0.f};
    bf16x8 At[4][2], B0[2][2], B1[2][2];
    const char* cA = (const char*)g.A + (size_t)cur.pm * tstepA + (size_t)cur.pn * g.apn * 2 + (size_t)cur.k0 * kstep; const char* cB = (const char*)g.Bt + (size_t)cur.pn * tstepB + (size_t)cur.k0 * kstep;
    PG8_STAGE(PG8_SB(0, 0), cB, voffB); PG8_STAGE(PG8_SB(0, 1), cB + hstepB, voffB); PG8_STAGE(PG8_SA(0, 0), cA, voffA); PG8_STAGE(PG8_SA(0, 1), cA + hstepA, voffA);
    if (wr == 1) PG8_BAR;
    PG8_WAIT_V(2); PG8_BAR;
    PG8_STAGE(PG8_SB(1, 0), cB + kstep, voffB); PG8_STAGE(PG8_SA(1, 0), cA + kstep, voffA); PG8_STAGE(PG8_SB(1, 1), cB + hstepB + kstep, voffB);
    PG8_WAIT_V(6); PG8_BAR;
    for (;;) {
        const bool has_next = S.next(ui + 1, nxt);
        const char* nA = has_next ? (const char*)g.A + (size_t)nxt.pm * tstepA + (size_t)nxt.pn * g.apn * 2 + (size_t)nxt.k0 * kstep : cA; const char* nB = has_next ? (const char*)g.Bt + (size_t)nxt.pn * tstepB + (size_t)nxt.k0 * kstep : cB;
        const int nt = cur.nk;
        float rsq[8]; E.pre(cur, wr, fr, rsq);
        for (int t = 0; t < nt; t += 2) {
            const bool last = (t == nt - 2);
            const char* a1 = cA + (size_t)(t + 1) * kstep;
            const char* a2 = last ? nA : cA + (size_t)(t + 2) * kstep; const char* b2 = last ? nB : cB + (size_t)(t + 2) * kstep;
            const char* a3 = a2 + kstep; const char* b3 = b2 + kstep;
            PG8_LDB(B0, 0, 0); PG8_LDB(B1, 0, 1); PG8_SCHED; PG8_LDA(At, 0, 0); PG8_STAGE(PG8_SA(1, 1), a1 + hstepA, voffA);
            PG8_WAIT_V(8); PG8_WAIT_L(0); PG8_BAR; PG8_MMA(0, 0, At, B0); PG8_MMA(0, 1, At, B1); PG8_BAR; PG8_SCHED;
            PG8_LDA(At, 0, 1); PG8_STAGE(PG8_SB(0, 0), b2, voffB); PG8_STAGE(PG8_SB(0, 1), b2 + hstepB, voffB); PG8_STAGE(PG8_SA(0, 0), a2, voffA);
            PG8_WAIT_V(8); PG8_WAIT_L(0); PG8_BAR; PG8_MMA(1, 0, At, B0); PG8_MMA(1, 1, At, B1); PG8_BAR; PG8_SCHED;
            PG8_LDB(B0, 1, 0); PG8_LDB(B1, 1, 1); PG8_SCHED; PG8_LDA(At, 1, 0); PG8_STAGE(PG8_SA(0, 1), a2 + hstepA, voffA);
            PG8_WAIT_V(8); PG8_WAIT_L(0); PG8_BAR; PG8_MMA(0, 0, At, B0); PG8_MMA(0, 1, At, B1); PG8_BAR; PG8_SCHED;
            PG8_LDA(At, 1, 1); PG8_STAGE(PG8_SB(1, 0), b3, voffB); PG8_STAGE(PG8_SB(1, 1), b3 + hstepB, voffB); PG8_STAGE(PG8_SA(1, 0), a3, voffA);
            PG8_WAIT_V(8); PG8_WAIT_L(0); PG8_BAR; PG8_MMA(1, 0, At, B0); PG8_MMA(1, 1, At, B1); PG8_BAR; PG8_SCHED;
        }
        if (wr == 0) PG8_BAR;
        if (cur.slot < 0) epi_all(E, acc, cur, wr, wc, fr, fq, rsq);
        else {
            const size_t lane_off = (size_t)(wr * 64 + fr) * BM + wc * 32 + 8 * fq;
            { float* mine = S.scratch + (size_t)((cur.slot - S.slot0) * S.SK + cur.k0 / cur.nk) * (BM * BM) + lane_off;
#pragma unroll
              for (int ai = 0; ai < 2; ++ai)
#pragma unroll
                for (int m = 0; m < 4; ++m) { __attribute__((address_space(1))) float* p = (__attribute__((address_space(1))) float*)(mine + (ai * HALF + m * 16) * BM); asm volatile("" : "+v"(p));
#pragma unroll
                    for (int bj = 0; bj < 2; ++bj) { *(__attribute__((address_space(1))) f32x4*)(p + bj * HALF) = acc[ai][bj][m][0]; *(__attribute__((address_space(1))) f32x4*)(p + bj * HALF + 4) = acc[ai][bj][m][1]; } } }
            asm volatile("s_waitcnt vmcnt(0)" ::: "memory"); PG8_BAR;
            PG8_LAS unsigned* flag = (PG8_LAS unsigned*)(lds + 131072 + 128);
            if (tid == 0) { __builtin_amdgcn_fence(__ATOMIC_RELEASE, "agent"); asm volatile("s_waitcnt vmcnt(0)" ::: "memory");
                *flag = __hip_atomic_fetch_add(S.cnt + cur.slot, 1u, __ATOMIC_RELAXED, __HIP_MEMORY_SCOPE_AGENT); }
            asm volatile("s_waitcnt vmcnt(0) lgkmcnt(0)" ::: "memory"); PG8_BAR; asm volatile("" ::: "memory");
            const unsigned old = *flag;
            if (old == (unsigned)(S.SK - 1)) {
                __builtin_amdgcn_fence(__ATOMIC_ACQUIRE, "agent");
                asm volatile("s_waitcnt vmcnt(0)" ::: "memory");
                const float* base = S.scratch + (size_t)((cur.slot - S.slot0) * S.SK) * (BM * BM) + lane_off;
                const int row0 = cur.pm * BM + wr * 64 + fr;
#pragma unroll
                for (int ai = 0; ai < 2; ++ai)
#pragma unroll
                    for (int m = 0; m < 4; ++m) {
                        f32x4 v[2][2] = {{{0.f, 0.f, 0.f, 0.f}, {0.f, 0.f, 0.f, 0.f}}, {{0.f, 0.f, 0.f, 0.f}, {0.f, 0.f, 0.f, 0.f}}};
                        for (int q = 0; q < S.SK; ++q) { const __attribute__((address_space(1))) float* p = (const __attribute__((address_space(1))) float*)(base + (size_t)q * (BM * BM) + (ai * HALF + m * 16) * BM); asm volatile("" : "+v"(p));
#pragma unroll
                            for (int bj = 0; bj < 2; ++bj) { v[bj][0] += *(const __attribute__((address_space(1))) f32x4*)(p + bj * HALF); v[bj][1] += *(const __attribute__((address_space(1))) f32x4*)(p + bj * HALF + 4); } }
                        E.row(v, cur, row0 + ai * HALF + m * 16, wc, fq, rsq[ai * 4 + m]);
                        asm volatile("" ::: "memory"); }
            }
        }
        if (!has_next) break;
#pragma unroll
        for (int a = 0; a < 2; ++a)
#pragma unroll
            for (int b = 0; b < 2; ++b)
#pragma unroll
                for (int m = 0; m < 4; ++m)
#pragma unroll
                    for (int n = 0; n < 2; ++n) acc[a][b][m][n] = (f32x4){0.f, 0.f, 0.f, 0.f};
        cur = nxt; cA = nA; cB = nB; ++ui;
        if (wr == 1) PG8_BAR;
    }
    PG8_WAIT_V(0);
    PG8_BAR;
#undef PG8_SA
#undef PG8_SB
#undef PG8_STAGE
#undef PG8_LDA
#undef PG8_LDB
#undef PG8_MMA
#undef PG8_WAIT_V
#undef PG8_WAIT_L
#undef PG8_BAR
#undef PG8_SCHED
}

template <class Epi> __device__ __forceinline__ void epi_all(const Epi& E, const f32x4 (&acc)[2][2][4][2], const Unit& u, int wr, int wc, int fr, int fq, const float (&rsq)[8]) {
    const int row0 = u.pm * BM + wr * 64 + fr;
#pragma unroll
    for (int ai = 0; ai < 2; ++ai)
#pragma unroll
        for (int m = 0; m < 4; ++m) { const f32x4 v[2][2] = {{acc[ai][0][m][0], acc[ai][0][m][1]}, {acc[ai][1][m][0], acc[ai][1][m][1]}}; E.row(v, u, row0 + ai * HALF + m * 16, wc, fq, rsq[ai * 4 + m]); }
}
__device__ __forceinline__ float silu_mul(float g, float u) { return g * __builtin_amdgcn_rcpf(1.0f + __builtin_amdgcn_exp2f(-1.4426950408889634f * g)) * u; }
typedef float f32x2 __attribute__((ext_vector_type(2)));
__device__ __forceinline__ f32x2 silu_mul2(f32x2 g, f32x2 u) {
    f32x2 x = g * (-1.4426950408889634f); x.x = fminf(x.x, 60.f); x.y = fminf(x.y, 60.f);
    f32x2 e; e.x = __builtin_amdgcn_exp2f(x.x); e.y = __builtin_amdgcn_exp2f(x.y);
    const f32x2 d = e + 1.0f; const float r = __builtin_amdgcn_rcpf(d.x * d.y);
    const f32x2 sg = (f32x2){d.y, d.x} * r;
    return (g * u) * sg;
}
struct EpiGU {
    bf16_t* H; const float* rowss;
    __device__ __forceinline__ void pre(const Unit& u, int wr, int fr, float (&r)[8]) const {
#pragma unroll
        for (int i = 0; i < 8; ++i) r[i] = rowss ? ld_agent(rowss + u.pm * BM + wr * 64 + fr + (i >> 2) * HALF + (i & 3) * 16) : 0.f; }
    __device__ __forceinline__ void row(const f32x4 (&v)[2][2], const Unit& u, int row, int wc, int fq, float rq) const {
        const int col0 = u.pn * 128 + wc * 32 + 8 * fq; const float rs = rowss ? 1.0f / sqrtf(rq * (1.0f / DM) + EPS) : 1.0f;
        const f32x4 g0 = v[0][0] * rs, g1 = v[0][1] * rs, u0 = v[1][0] * rs, u1 = v[1][1] * rs;
        const f32x2 a = silu_mul2((f32x2){g0[0], g0[1]}, (f32x2){u0[0], u0[1]}), b = silu_mul2((f32x2){g0[2], g0[3]}, (f32x2){u0[2], u0[3]});
        const f32x2 c = silu_mul2((f32x2){g1[0], g1[1]}, (f32x2){u1[0], u1[1]}), d = silu_mul2((f32x2){g1[2], g1[3]}, (f32x2){u1[2], u1[3]});
        u32x4 w; w.x = cvt_pk_bf16(a.x, a.y); w.y = cvt_pk_bf16(b.x, b.y); w.z = cvt_pk_bf16(c.x, c.y); w.w = cvt_pk_bf16(d.x, d.y);
        *(u32x4*)(H + (size_t)row * DFF + col0) = w;
    }
};
struct EpiRes {
    const float* resid_p; const float* resid_s; const bf16_t* rbf; float alpha; bf16_t* hb; float* rowss;
    __device__ __forceinline__ void pre(const Unit&, int, int, float (&r)[8]) const {
#pragma unroll
        for (int i = 0; i < 8; ++i) r[i] = 0.f; }
    __device__ __forceinline__ void row(const f32x4 (&v)[2][2], const Unit& u, int row, int wc, int fq, float) const {
        const int col0 = u.pn * BM + wc * 32 + 8 * fq;
        const float* rbase = (u.pm < MP / BM) ? resid_p : resid_s - (size_t)MP * DM;
        const size_t off = (size_t)row * DM + col0; float ss = 0.f;
#pragma unroll
        for (int bj = 0; bj < 2; ++bj) {
            f32x4 r0, r1;
            if (rbf) { const u32x4 w = *(const u32x4*)(rbf + off + bj * HALF);
                r0 = (f32x4){__uint_as_float(w.x << 16), __uint_as_float(w.x & 0xffff0000u), __uint_as_float(w.y << 16), __uint_as_float(w.y & 0xffff0000u)};
                r1 = (f32x4){__uint_as_float(w.z << 16), __uint_as_float(w.z & 0xffff0000u), __uint_as_float(w.w << 16), __uint_as_float(w.w & 0xffff0000u)}; }
            else { r0 = *(const f32x4*)(rbase + off + bj * HALF); r1 = *(const f32x4*)(rbase + off + bj * HALF + 4); }
            const f32x4 v0 = r0 + v[bj][0] * alpha, v1 = r1 + v[bj][1] * alpha;
            ss += (v0[0] * v0[0] + v0[1] * v0[1]) + (v0[2] * v0[2] + v0[3] * v0[3]) + (v1[0] * v1[0] + v1[1] * v1[1]) + (v1[2] * v1[2] + v1[3] * v1[3]);
            u32x4 w; w.x = cvt_pk_bf16(v0[0], v0[1]); w.y = cvt_pk_bf16(v0[2], v0[3]); w.z = cvt_pk_bf16(v1[0], v1[1]); w.w = cvt_pk_bf16(v1[2], v1[3]);
            *(u32x4*)(hb + off + bj * HALF) = w; }
        ss += __shfl_xor(ss, 16); ss += __shfl_xor(ss, 32);
        if (fq == 0) atomicAdd(rowss + row, ss);
    }
};
__device__ __forceinline__ float log_sigmoid(float z) { return fminf(z, 0.f) - log1pf(expf(-fabsf(z))); }
struct EpiIn {
    const float* rowss; float* out; bf16_t* Qb; bf16_t* Kb; bf16_t* Vb; float* Pb; const float* bfp; float* NQ2; float* NK2;
    __device__ __forceinline__ void pre(const Unit& u, int wr, int fr, float (&r)[8]) const {
#pragma unroll
        for (int i = 0; i < 8; ++i) r[i] = ld_agent(rowss + u.pm * BM + wr * 64 + fr + (i >> 2) * HALF + (i & 3) * 16); }
    __device__ __forceinline__ void row(const f32x4 (&v)[2][2], const Unit& u, int row, int wc, int fq, float rq) const {
        const int sec = u.pn >> 2, cbase = (u.pn & 3) * BM + wc * 32 + 8 * fq; const bool samp = u.pm >= MP / BM;
        const float rs = 1.0f / sqrtf(rq * (1.0f / DM) + EPS);
        size_t hm; int hs;
        if (!samp) { const int b = row >> 13, t = row & (SEQ - 1); hm = ((size_t)b * NH * SEQ + t) * HD; hs = SEQ * HD; }
        else { const int ms = row - MP, b = ms >> 5, t = ms & 31; hm = (size_t)MP * FOXW + ((size_t)b * NH * ST + t) * HD; hs = ST * HD; }
#pragma unroll
        for (int bj = 0; bj < 2; ++bj) { const int col = cbase + bj * HALF; const f32x4 v0 = v[bj][0] * rs, v1 = v[bj][1] * rs;
            const int h = col >> 7, d = col & 127;
            if (sec < 2 && !samp) { float ss = (v0[0] * v0[0] + v0[1] * v0[1]) + (v0[2] * v0[2] + v0[3] * v0[3]) + (v1[0] * v1[0] + v1[1] * v1[1]) + (v1[2] * v1[2] + v1[3] * v1[3]);
                ss += __shfl_xor(ss, 16); ss += __shfl_xor(ss, 32); if (fq == 0) atomicAdd((sec == 0 ? NQ2 : NK2) + (size_t)row * NH + h, ss); }
            if (sec == 0) { u32x4 w; w.x = cvt_pk_bf16(v0[0], v0[1]); w.y = cvt_pk_bf16(v0[2], v0[3]); w.z = cvt_pk_bf16(v1[0], v1[1]); w.w = cvt_pk_bf16(v1[2], v1[3]);
                *(u32x4*)(Qb + hm + (size_t)h * hs + d) = w; }
            else if (sec == 1 || sec == 2) {
                float* o = out + (samp ? (sec == 1 ? O_KS : O_VS) + (size_t)(row - MP) * FOXW : (sec == 1 ? O_KP : O_VP) + (size_t)row * FOXW) + col;
                *(f32x4*)o = v0; *(f32x4*)(o + 4) = v1;
                if (!samp) { u32x4 w; w.x = cvt_pk_bf16(v0[0], v0[1]); w.y = cvt_pk_bf16(v0[2], v0[3]); w.z = cvt_pk_bf16(v1[0], v1[1]); w.w = cvt_pk_bf16(v1[2], v1[3]);
                    *(u32x4*)((sec == 1 ? Kb : Vb) + hm + (size_t)h * hs + d) = w; } }
            else if (sec == 3) { float* o = Pb + (size_t)row * POOLW + col; *(f32x4*)o = v0; *(f32x4*)(o + 4) = v1; }
            else { if (bj == 0 && wc == 0 && fq == 0) { float* o = out + (samp ? O_LFS + (size_t)(row - MP) * NH : O_LFP + (size_t)row * NH);
                    f32x4 l0, l1;
#pragma unroll
                    for (int j = 0; j < 4; ++j) { l0[j] = log_sigmoid(v0[j] + bfp[j]); l1[j] = log_sigmoid(v1[j] + bfp[4 + j]); }
                    *(f32x4*)o = l0; *(f32x4*)(o + 4) = l1; } } }
    }
};
struct EpiPool {
    bf16_t* MIX; const float* scale;
    __device__ __forceinline__ void pre(const Unit&, int, int, float (&r)[8]) const {
#pragma unroll
        for (int i = 0; i < 8; ++i) r[i] = 0.f; }
    __device__ __forceinline__ void row(const f32x4 (&v)[2][2], const Unit& u, int row, int wc, int fq, float) const {
        const int col0 = u.pn * BM + wc * 32 + 8 * fq;
#pragma unroll
        for (int bj = 0; bj < 2; ++bj) { const f32x4 v0 = v[bj][0] * *(const f32x4*)(scale + col0 + bj * HALF), v1 = v[bj][1] * *(const f32x4*)(scale + col0 + bj * HALF + 4);
            u32x4 w; w.x = cvt_pk_bf16(v0[0], v0[1]); w.y = cvt_pk_bf16(v0[2], v0[3]); w.z = cvt_pk_bf16(v1[0], v1[1]); w.w = cvt_pk_bf16(v1[2], v1[3]);
            *(u32x4*)(MIX + (size_t)row * DM + FOXW + col0 + bj * HALF) = w; }
    }
};
struct EpiFold {
    bf16_t* WoT;
    __device__ __forceinline__ void pre(const Unit&, int, int, float (&r)[8]) const {
#pragma unroll
        for (int i = 0; i < 8; ++i) r[i] = 0.f; }
    __device__ __forceinline__ void row(const f32x4 (&v)[2][2], const Unit& u, int row, int wc, int fq, float) const {
        const int col0 = FOXW + u.pn * BM + wc * 32 + 8 * fq;
#pragma unroll
        for (int bj = 0; bj < 2; ++bj) { u32x4 w; w.x = cvt_pk_bf16(v[bj][0][0], v[bj][0][1]); w.y = cvt_pk_bf16(v[bj][0][2], v[bj][0][3]); w.z = cvt_pk_bf16(v[bj][1][0], v[bj][1][1]); w.w = cvt_pk_bf16(v[bj][1][2], v[bj][1][3]);
            *(u32x4*)(WoT + (size_t)row * DM + col0 + bj * HALF) = w; }
    }
};
}

namespace fox {
constexpr int D = 128, OST = DM;
constexpr float SCALE = 0.08838834764831845f, INV_SCALE = 11.313708498984761f;
constexpr float THR = 32.f;
constexpr int NW = 8, QBLK = 32, KVBLK = 64, QB = NW * QBLK;
constexpr int SHM_V = KVBLK * D * 2, SHM_K = KVBLK * D * 2;
constexpr int LDS_ATT = 2 * SHM_V + 2 * SHM_K + NW * 64 * 4;
constexpr int LDS_BIAS = 69632;
#define KSWZ(row, colB) ((row) * 256 + ((colB) ^ (((row) & 7) << 4)))
#define SBAR() __builtin_amdgcn_sched_barrier(0)
__device__ __forceinline__ int v_st(int k, int c) { const int kk = (k & ~0xC) | ((k & 4) << 1) | ((k & 8) >> 1); return ((kk >> 3) * 4 + (c >> 5)) * 512 + ((kk & 7) * 32 + (c & 31)) * 2; }
__device__ __forceinline__ int v_rd_base(int lane) { return ((lane & 3) << 3) | (((lane >> 2) & 3) << 6) | (((lane >> 4) & 1) << 5) | (((lane >> 5) & 1) << 8); }
constexpr int v_rd_off(int d0, int ks, int half) { return d0 * 512 + ks * 4096 + half * 2048; }
__device__ __forceinline__ int crow(int r, int hi) { return (r & 3) + 8 * (r >> 2) + 4 * hi; }
__device__ __forceinline__ bf16x8 pack8(f32x4 a, f32x4 b) { u32x4 w = {cvt_pk_bf16(a[0], a[1]), cvt_pk_bf16(a[2], a[3]), cvt_pk_bf16(b[0], b[1]), cvt_pk_bf16(b[2], b[3])}; return *reinterpret_cast<bf16x8*>(&w); }
__device__ __forceinline__ bf16x8 load8h(const bf16_t* p) { return *reinterpret_cast<const bf16x8*>(p); }
__device__ __forceinline__ bf16x8 load8f(const float* p) { return pack8(*(const f32x4*)p, *(const f32x4*)(p + 4)); }
__device__ __forceinline__ void mask_tile(f32x16& p0, f32x16& p1, int dq, unsigned W) {
    const float NEG = -__builtin_inff();
#pragma unroll
    for (int r = 0; r < 16; ++r) { const int c = (r & 3) + 8 * (r >> 2);
        if ((unsigned)(dq - c) >= W) p0[r] = NEG;
        if ((unsigned)(dq - c - 32) >= W) p1[r] = NEG; }
}
__device__ __forceinline__ void partialSM(f32x16& p0, f32x16& p1, float& m_reg, float& mn, float& alpha) {
    float pmax = p0[0];
#pragma unroll
    for (int r = 1; r < 16; ++r) pmax = fmaxf(pmax, p0[r]);
#pragma unroll
    for (int r = 0; r < 16; ++r) pmax = fmaxf(pmax, p1[r]);
    { auto rr = __builtin_amdgcn_permlane32_swap(__float_as_uint(pmax), __float_as_uint(pmax), false, false);
      pmax = fmaxf(__uint_as_float(rr[0]), __uint_as_float(rr[1])); }
    constexpr float C2 = 1.4426950408889634f * SCALE;
    if (__builtin_expect(__all((pmax - m_reg) * SCALE <= THR), 1)) { mn = m_reg; alpha = 1.f; }
    else { mn = fmaxf(m_reg, pmax); alpha = __builtin_amdgcn_exp2f((m_reg - mn) * C2); m_reg = mn; }
    const float mnL = -mn * C2;
#pragma unroll
    for (int r = 0; r < 16; ++r) p0[r] = fmaf(p0[r], C2, mnL);
#pragma unroll
    for (int r = 0; r < 16; ++r) p1[r] = fmaf(p1[r], C2, mnL);
#pragma unroll
    for (int r = 0; r < 16; ++r) p0[r] = __builtin_amdgcn_exp2f(p0[r]);
}
__device__ __forceinline__ void finishSM(f32x16& p0, f32x16& p1, float alpha, float& l_reg, bf16x8& pa0, bf16x8& pa1, bf16x8& pa2, bf16x8& pa3) {
#pragma unroll
    for (int r = 0; r < 16; ++r) p1[r] = __builtin_amdgcn_exp2f(p1[r]);
    float ps = 0;
#pragma unroll
    for (int r = 0; r < 16; ++r) ps += p0[r];
#pragma unroll
    for (int r = 0; r < 16; ++r) ps += p1[r];
    { auto rr = __builtin_amdgcn_permlane32_swap(__float_as_uint(ps), __float_as_uint(ps), false, false);
      ps = __uint_as_float(rr[0]) + __uint_as_float(rr[1]); }
    l_reg = l_reg * alpha + ps;
#define PK4(P, B_, OUT) do { unsigned a0 = cvt_pk_bf16(P[B_+0], P[B_+1]), a1 = cvt_pk_bf16(P[B_+2], P[B_+3]);                          \
        unsigned b0 = cvt_pk_bf16(P[B_+4], P[B_+5]), b1 = cvt_pk_bf16(P[B_+6], P[B_+7]);                                             \
        auto r0 = __builtin_amdgcn_permlane32_swap(a0, b0, false, false); auto r1 = __builtin_amdgcn_permlane32_swap(a1, b1, false, false); \
        u32x4 w = {r0[0], r1[0], r0[1], r1[1]}; OUT = *reinterpret_cast<bf16x8*>(&w); } while (0)
    PK4(p0, 0, pa0); PK4(p0, 8, pa1); PK4(p1, 0, pa2); PK4(p1, 8, pa3);
#undef PK4
}
typedef __attribute__((address_space(3))) const float* lds_cf;
__device__ __forceinline__ void bias_init(f32x16& p0, f32x16& p1, lds_cf bt) {
#pragma unroll
    for (int g = 0; g < 4; ++g) { const f32x4 a = *(const __attribute__((address_space(3))) f32x4*)(bt + 8 * g), b = *(const __attribute__((address_space(3))) f32x4*)(bt + 32 + 8 * g);
        p0[4 * g] = a[0]; p0[4 * g + 1] = a[1]; p0[4 * g + 2] = a[2]; p0[4 * g + 3] = a[3];
        p1[4 * g] = b[0]; p1[4 * g + 1] = b[1]; p1[4 * g + 2] = b[2]; p1[4 * g + 3] = b[3]; }
}
template <int KB>
__device__ __forceinline__ void qkt(f32x16& p0, f32x16& p1, const char* K_lds, int r32, int hi, const bf16x8* qr, lds_cf bt) {
    bias_init(p0, p1, bt);
    const char* kb[4];
#pragma unroll
    for (int dd = 0; dd < 4; ++dd) kb[dd] = K_lds + KB * SHM_K + KSWZ(r32, (dd * 16 + hi * 8) * 2);
#pragma unroll
    for (int d0 = 0; d0 < 8; ++d0) { const char* a = kb[d0 & 3] + (d0 >> 2) * 128;
        bf16x8 b0 = *reinterpret_cast<const bf16x8*>(a);
        bf16x8 b1 = *reinterpret_cast<const bf16x8*>(a + 32 * 256);
        p0 = __builtin_amdgcn_mfma_f32_32x32x16_bf16(b0, qr[d0], p0, 0, 0, 0);
        p1 = __builtin_amdgcn_mfma_f32_32x32x16_bf16(b1, qr[d0], p1, 0, 0, 0); }
}
template <int VB>
__device__ __forceinline__ void pv_tile(f32x16* o, int vb0, bf16x8 pa0, bf16x8 pa1, bf16x8 pa2, bf16x8 pa3) {
#define TRRD(dst, off) asm volatile("ds_read_b64_tr_b16 %0, %1 offset:%2" : "=&v"(dst) : "v"(vb0), "i"(off) : "memory")
#define PV_D0(d0) do { s16x4 l0, l1, l2, l3, h0, h1, h2, h3; constexpr int b_ = VB * SHM_V + v_rd_off(d0, 0, 0); \
        TRRD(l0, b_); TRRD(h0, b_ + 2048); TRRD(l1, b_ + 4096); TRRD(h1, b_ + 6144); TRRD(l2, b_ + 8192); TRRD(h2, b_ + 10240); TRRD(l3, b_ + 12288); TRRD(h3, b_ + 14336); \
        asm volatile("s_waitcnt lgkmcnt(0)" ::: "memory"); SBAR();   \
        o[d0] = __builtin_amdgcn_mfma_f32_32x32x16_bf16(pa0, (bf16x8){l0[0], l0[1], l0[2], l0[3], h0[0], h0[1], h0[2], h0[3]}, o[d0], 0, 0, 0);   \
        o[d0] = __builtin_amdgcn_mfma_f32_32x32x16_bf16(pa1, (bf16x8){l1[0], l1[1], l1[2], l1[3], h1[0], h1[1], h1[2], h1[3]}, o[d0], 0, 0, 0);   \
        o[d0] = __builtin_amdgcn_mfma_f32_32x32x16_bf16(pa2, (bf16x8){l2[0], l2[1], l2[2], l2[3], h2[0], h2[1], h2[2], h2[3]}, o[d0], 0, 0, 0);   \
        o[d0] = __builtin_amdgcn_mfma_f32_32x32x16_bf16(pa3, (bf16x8){l3[0], l3[1], l3[2], l3[3], h3[0], h3[1], h3[2], h3[3]}, o[d0], 0, 0, 0); } while (0)
    PV_D0(0); PV_D0(1); PV_D0(2); PV_D0(3);
#undef PV_D0
#undef TRRD
}
struct BlockRef { const bf16_t* K; bf16_t* O; const float* C; int P0; float nrm;
    __device__ __forceinline__ const bf16_t* Vp() const { return K + (WS_V - WS_K) / 2; }
    __device__ __forceinline__ const bf16_t* Qp() const { return K - (WS_K - WS_Q) / 2 + (size_t)P0 * D; } };
struct Seam { bf16x8 qr[8]; bf16x8 st_v0, st_v1, st_k0, st_k1; };
#define ROW(p, k0, rr) ((p) + (size_t)((k0) + (rr)) * D + sc)
#define VMW() asm volatile("s_waitcnt vmcnt(0)" ::: "memory")
#define VMWN(n) asm volatile("s_waitcnt vmcnt(%0)" :: "i"(n) : "memory")
#define SLOAD_H(Kp, Vp, k0) do { S.st_v0 = load8h(ROW(Vp, k0, sr)); S.st_v1 = load8h(ROW(Vp, k0, 32 + sr));              \
                         S.st_k0 = load8h(ROW(Kp, k0, sr)); S.st_k1 = load8h(ROW(Kp, k0, 32 + sr)); } while (0)
#define SWRITE_HK(bf) do { *(bf16x8*)(K_lds + (bf) * SHM_K + kws) = S.st_k0; *(bf16x8*)(K_lds + (bf) * SHM_K + kws + 32 * 256) = S.st_k1; } while (0)
#define SWRITE_HV(bf) do { *(bf16x8*)(V_lds + (bf) * SHM_V + vst0) = S.st_v0; *(bf16x8*)(V_lds + (bf) * SHM_V + vst1) = S.st_v1; } while (0)
#define SWRITE_H(bf) do { SWRITE_HV(bf); SWRITE_HK(bf); } while (0)
__device__ __forceinline__ void prime(const BlockRef& cur, char* lds, Seam& S) {
    int tid_ = threadIdx.x; asm volatile("" : "+v"(tid_)); const int tid = tid_, wid = __builtin_amdgcn_readfirstlane(tid >> 6), lane = tid & 63, r32 = lane & 31, hi = lane >> 5;
#pragma unroll
    for (int d0 = 0; d0 < 8; ++d0) S.qr[d0] = load8h(cur.Qp() + (size_t)(wid * QBLK + r32) * D + d0 * 16 + hi * 8);
    __syncthreads();
}
__device__ __forceinline__ void block(const BlockRef& cur, const BlockRef& nxt, char* lds, Seam& S) {
    int tid_ = threadIdx.x; asm volatile("" : "+v"(tid_)); const int tid = tid_, wid = __builtin_amdgcn_readfirstlane(tid >> 6), lane = tid & 63, r32 = lane & 31, hi = lane >> 5;
    const int NTC = (cur.P0 + QB) / KVBLK;
    const unsigned W = 0x40000000u;
    const int qlo = cur.P0 + wid * QBLK, qm = qlo + r32 - 4 * hi;
    char* V_lds = lds; char* K_lds = lds + 2 * SHM_V;
    float* ws = (float*)(lds + 2 * SHM_V + 2 * SHM_K) + wid * 64; float* li_l = ws, * al_l = ws + 32;
    float* bias = (float*)(lds + LDS_BIAS);
    { const float cref = cur.C[cur.P0]; const int n4 = (cur.P0 + QB) >> 2; int tl = threadIdx.x; asm volatile("" : "+v"(tl));
      for (int i = tl; i < n4; i += 512) { const f32x4 c4 = *(const f32x4*)(cur.C + 4 * i); *(f32x4*)(bias + 4 * i) = (cref - c4) * INV_SCALE; } }
    __syncthreads();
    int* jl = (int*)(lds + LDS_BIAS - 16);
    if (wid == 0) { const float lim = -(88.0f + 2.0f * cur.nrm) * INV_SCALE; const int t1 = lane + 64;
        const bool d0 = lane < NTC && bias[64 * lane + 63] < lim, d1 = t1 < NTC && bias[64 * t1 + 63] < lim;
        int cnt = __popcll(__ballot(d0)) + __popcll(__ballot(d1)); cnt &= ~1; if (cnt > NTC - 4) cnt = NTC - 4;
        if (lane == 0) *jl = cnt; }
    __syncthreads();
    const int j_lo = __builtin_amdgcn_readfirstlane(*jl), NT = NTC - j_lo;
    const lds_cf bt0 = (lds_cf)(__attribute__((address_space(3))) char*)lds + LDS_BIAS / 4 + 4 * hi;
    float m_reg = -1e30f, l_reg = 0; f32x16 o[4] = {};
    const int sr = tid >> 4, sc = (tid & 15) * 8, vst0 = v_st(sr, sc), vst1 = v_st(32 + sr, sc), kws = KSWZ(sr, sc * 2);
    const int vb0 = (int)(uintptr_t)V_lds + v_rd_base(lane);
    const bf16_t* Kh = cur.K; const bf16_t* Vh = cur.Vp();
#define RESC(a) do { if (__any((a) < 1.f)) { if (hi == 0) al_l[r32] = (a); asm volatile("s_waitcnt lgkmcnt(0)" ::: "memory");              \
                     for (int d_ = 0; d_ < 4; ++d_) for (int r = 0; r < 16; ++r) o[d_][r] *= al_l[crow(r, hi)]; } } while (0)
#define KBASE(t) ((j_lo + (t)) * KVBLK)
#define MASKT(P0_, P1_, t) do { const int kb_ = KBASE(t); if (kb_ + KVBLK - 1 > qlo) mask_tile(P0_, P1_, qm - kb_, W); } while (0)
    f32x16 pA0, pA1, pB0, pB1; float mnA, mnB, alA, alB; bf16x8 pa0, pa1, pa2, pa3;
    SLOAD_H(Kh, Vh, KBASE(0)); VMW(); SWRITE_HK(0); __syncthreads();
    SWRITE_HV(0); SBAR();
    if (NT > 1) { SLOAD_H(Kh, Vh, KBASE(1)); }
    SBAR(); qkt<0>(pA0, pA1, K_lds, r32, hi, S.qr, bt0 + KBASE(0));
    MASKT(pA0, pA1, 0); partialSM(pA0, pA1, m_reg, mnA, alA);
    if (NT > 1) { VMW(); SWRITE_H(1); }
    __syncthreads();
#define HALF_STEP(PX0, PX1, mnX, alX, PY0, PY1, alY, t, KB, VB, SB) do {                                                      \
        SBAR(); qkt<KB>(PX0, PX1, K_lds, r32, hi, S.qr, bt0 + KBASE(t));                                                     \
        finishSM(PY0, PY1, alY, l_reg, pa0, pa1, pa2, pa3); SBAR();                                                           \
        if ((t) + 1 < NT) { SLOAD_H(Kh, Vh, KBASE((t) + 1)); SBAR(); }                                                        \
        pv_tile<VB>(o, vb0, pa0, pa1, pa2, pa3); MASKT(PX0, PX1, (t)); partialSM(PX0, PX1, m_reg, mnX, alX);                \
        __syncthreads();                                                                                                      \
        if ((t) + 1 < NT) { VMW(); SWRITE_H(SB); }                                                                            \
        RESC(alX); __syncthreads(); } while (0)
    for (int t = 1; t + 1 < NT; t += 2) {
        HALF_STEP(pB0, pB1, mnB, alB, pA0, pA1, alA, t, 1, 0, 0);
        HALF_STEP(pA0, pA1, mnA, alA, pB0, pB1, alB, t + 1, 0, 1, 1);
    }
    SBAR(); qkt<1>(pB0, pB1, K_lds, r32, hi, S.qr, bt0 + KBASE(NT - 1)); SBAR();
#pragma unroll
    for (int d0 = 0; d0 < 8; ++d0) S.qr[d0] = load8h(nxt.Qp() + (size_t)(wid * QBLK + r32) * D + d0 * 16 + hi * 8);
    SBAR();
    finishSM(pA0, pA1, alA, l_reg, pa0, pa1, pa2, pa3); SBAR();
    pv_tile<0>(o, vb0, pa0, pa1, pa2, pa3);
    MASKT(pB0, pB1, NT - 1); partialSM(pB0, pB1, m_reg, mnB, alB); __syncthreads(); RESC(alB);
    finishSM(pB0, pB1, alB, l_reg, pa0, pa1, pa2, pa3); SBAR(); pv_tile<1>(o, vb0, pa0, pa1, pa2, pa3);
    SBAR();
    if (hi == 0) li_l[r32] = l_reg; asm volatile("s_waitcnt lgkmcnt(0)" ::: "memory");
    float rli[16];
#pragma unroll
    for (int r = 0; r < 16; ++r) rli[r] = __builtin_amdgcn_rcpf(li_l[crow(r, hi)]);
    bf16_t* Ow = cur.O + (size_t)(wid * QBLK) * OST;
#pragma unroll
    for (int r = 0; r < 16; ++r) { const int orow = crow(r, hi);
#pragma unroll
        for (int d0 = 0; d0 < 4; ++d0) { const float v = o[d0][r] * rli[r];
            const float vn = __shfl_xor(v, 1);
            if ((r32 & 1) == 0) *(unsigned*)(Ow + (size_t)orow * OST + d0 * 32 + r32) = cvt_pk_bf16(v, vn); } }
    __syncthreads();
#undef RESC
#undef KBASE
#undef MASKT
#undef HALF_STEP
}
#undef ROW
#undef VMWN
#undef SLOAD_H
#undef SWRITE_HK
#undef SWRITE_HV
#undef SWRITE_H

__device__ __forceinline__ void sample_unit(int b, int h, const float* cache_k, const float* cache_v, const float* cache_lf, const float* ks_new, const float* vs_new, const float* lf_new,
                                            const bf16_t* Qs, bf16_t* MIXs, char* lds) {
    int tid_ = threadIdx.x; asm volatile("" : "+v"(tid_)); const int tid = tid_, wid = __builtin_amdgcn_readfirstlane(tid >> 6), lane = tid & 63, r32 = lane & 31, hi = lane >> 5;
    float* bias = (float*)lds;
    float* mw = (float*)(lds + 8192);
    float* lw = mw + 256;
    float* alw = lw + 256 + wid * 64;
    float* obuf = (float*)(lds + 16384);
    constexpr int NKEY = PAST + ST;
    for (int s = tid; s < 1088; s += 512) { float v = 0.f; if (s < PAST) v = cache_lf[((size_t)b * PAST + s) * NH + h]; else if (s < NKEY) v = lf_new[((size_t)b * ST + (s - PAST)) * NH + h]; bias[s] = v; }
    __syncthreads();
    if (wid == 0) { float carry = 0.f;
        for (int ch = 0; ch < 17; ++ch) { float v = bias[ch * 64 + lane];
#pragma unroll
            for (int o = 1; o < 64; o <<= 1) { const float t = __shfl_up(v, o); if (lane >= o) v += t; }
            v += carry; carry = __shfl(v, 63); bias[ch * 64 + lane] = v; } }
    __syncthreads();
    const float cref = bias[PAST];
    __syncthreads();
    for (int s = tid; s < 1088; s += 512) bias[s] = (cref - bias[s]) * INV_SCALE;
    __syncthreads();
    bf16x8 qr[8];
#pragma unroll
    for (int d0 = 0; d0 < 8; ++d0) qr[d0] = load8h(Qs + ((size_t)(b * NH + h) * ST + r32) * D + d0 * 16 + hi * 8);
    float m_reg = -1e30f, l_reg = 0.f; f32x16 o[4] = {};
    const int ntile = (wid == 0) ? 3 : 2;
    for (int ti = 0; ti < ntile; ++ti) {
        const int T = (ti < 2) ? 2 * wid + ti : 16; const bool newt = (T == 16);
        const float* Kb = newt ? ks_new + ((size_t)b * ST * NH + h) * D : cache_k + (((size_t)b * PAST + T * 64) * NH + h) * D;
        const float* Vb = newt ? vs_new + ((size_t)b * ST * NH + h) * D : cache_v + (((size_t)b * PAST + T * 64) * NH + h) * D;
        f32x16 p0, p1; bias_init(p0, p1, (lds_cf)(__attribute__((address_space(3))) char*)lds + T * 64 + 4 * hi);
#pragma unroll
        for (int d0 = 0; d0 < 8; ++d0) {
            const bf16x8 b0 = load8f(Kb + (size_t)r32 * (NH * D) + d0 * 16 + hi * 8);
            p0 = __builtin_amdgcn_mfma_f32_32x32x16_bf16(b0, qr[d0], p0, 0, 0, 0);
            if (!newt) { const bf16x8 b1 = load8f(Kb + (size_t)(32 + r32) * (NH * D) + d0 * 16 + hi * 8);
                p1 = __builtin_amdgcn_mfma_f32_32x32x16_bf16(b1, qr[d0], p1, 0, 0, 0); } }
        if (newt) { const float NEG = -__builtin_inff();
#pragma unroll
            for (int r = 0; r < 16; ++r) { if (crow(r, hi) > r32) p0[r] = NEG; p1[r] = NEG; } }
        float mn, alpha; bf16x8 pa[4];
        partialSM(p0, p1, m_reg, mn, alpha);
        if (__any(alpha < 1.f)) { if (hi == 0) alw[r32] = alpha; asm volatile("s_waitcnt lgkmcnt(0)" ::: "memory");
#pragma unroll
            for (int d_ = 0; d_ < 4; ++d_)
#pragma unroll
                for (int r = 0; r < 16; ++r) o[d_][r] *= alw[crow(r, hi)]; }
        finishSM(p0, p1, alpha, l_reg, pa[0], pa[1], pa[2], pa[3]);
        const int nks = newt ? 2 : 4;
#pragma unroll
        for (int d0 = 0; d0 < 4; ++d0)
#pragma unroll
            for (int ks = 0; ks < 4; ++ks) if (ks < nks) {
                const float* vp = Vb + (size_t)(16 * ks + 8 * hi) * (NH * D) + d0 * 32 + r32;
                f32x4 a, c;
#pragma unroll
                for (int e = 0; e < 4; ++e) { a[e] = vp[(size_t)e * (NH * D)]; c[e] = vp[(size_t)(4 + e) * (NH * D)]; }
                o[d0] = __builtin_amdgcn_mfma_f32_32x32x16_bf16(pa[ks], pack8(a, c), o[d0], 0, 0, 0); }
    }
    constexpr float C2 = 1.4426950408889634f * SCALE;
    if (hi == 0) mw[wid * 32 + r32] = m_reg;
    __syncthreads();
    float Mx = mw[r32];
#pragma unroll
    for (int w = 1; w < 8; ++w) Mx = fmaxf(Mx, mw[w * 32 + r32]);
    const float f = __builtin_amdgcn_exp2f((m_reg - Mx) * C2);
    if (hi == 0) { lw[wid * 32 + r32] = l_reg * f; alw[r32] = f; }
    asm volatile("s_waitcnt lgkmcnt(0)" ::: "memory");
#pragma unroll
    for (int d_ = 0; d_ < 4; ++d_)
#pragma unroll
        for (int r = 0; r < 16; ++r) o[d_][r] *= alw[crow(r, hi)];
    for (int w = 0; w < 8; ++w) {
        if (wid == w) {
#pragma unroll
            for (int d0 = 0; d0 < 4; ++d0)
#pragma unroll
                for (int r = 0; r < 16; ++r) { float* p = obuf + crow(r, hi) * 128 + d0 * 32 + r32; if (w == 0) *p = o[d0][r]; else *p += o[d0][r]; } }
        __syncthreads();
    }
    { const int q = tid >> 4, d8 = (tid & 15) * 8; float L = 0.f;
#pragma unroll
      for (int w = 0; w < 8; ++w) L += lw[w * 32 + q];
      const float rl = 1.0f / L; const f32x4 a = *(const f32x4*)(obuf + q * 128 + d8) * rl, c = *(const f32x4*)(obuf + q * 128 + d8 + 4) * rl;
      u32x4 wv = {cvt_pk_bf16(a[0], a[1]), cvt_pk_bf16(a[2], a[3]), cvt_pk_bf16(c[0], c[1]), cvt_pk_bf16(c[2], c[3])};
      *(u32x4*)(MIXs + ((size_t)b * ST + q) * DM + h * HD + d8) = wv; }
    __syncthreads();
}
#undef VMW
#undef SBAR
#undef KSWZ
}

#define LAS __attribute__((address_space(3)))
__device__ __forceinline__ unsigned f2bf(float f) { unsigned u = __builtin_bit_cast(unsigned, f); return (u + 0x7fffu + ((u >> 16) & 1u)) >> 16; }
__device__ __forceinline__ unsigned pk2(float lo, float hi) { return f2bf(lo) | (f2bf(hi) << 16); }
__device__ __forceinline__ float wave_sum(float v) {
#pragma unroll
    for (int o = 1; o < 64; o <<= 1) v += __shfl_xor(v, o);
    return v;
}
__device__ __forceinline__ void transpose_item(const float* Wblk, int ldw, bf16_t* WT, int K, int drow0, int k0, LAS float* scr, int lane, const float* kg = nullptr) {
    const int kr = lane >> 3, nq = lane & 7;
    f32x4 v[8];
#pragma unroll
    for (int i = 0; i < 8; ++i) { v[i] = *(const f32x4*)(Wblk + (size_t)(k0 + 8 * i + kr) * ldw + 4 * nq); if (kg) v[i] = v[i] * kg[k0 + 8 * i + kr]; }
#pragma unroll
    for (int i = 0; i < 8; ++i) { LAS float* d = scr + (8 * i + kr) * 33 + 4 * nq; d[0] = v[i][0]; d[1] = v[i][1]; d[2] = v[i][2]; d[3] = v[i][3]; }
    asm volatile("s_waitcnt lgkmcnt(0)" ::: "memory");
    const int c = lane & 7;
#pragma unroll
    for (int j = 0; j < 4; ++j) { const int n = (lane >> 3) + 8 * j; const LAS float* s = scr + (8 * c) * 33 + n;
        u32x4 o; o.x = cvt_pk_bf16(s[0 * 33], s[1 * 33]); o.y = cvt_pk_bf16(s[2 * 33], s[3 * 33]); o.z = cvt_pk_bf16(s[4 * 33], s[5 * 33]); o.w = cvt_pk_bf16(s[6 * 33], s[7 * 33]);
        *(u32x4*)(WT + (size_t)(drow0 + n) * K + k0 + 8 * c) = o; }
    asm volatile("s_waitcnt lgkmcnt(0)" ::: "memory");
}

#define XB_TMO      128
#define XB_XCNT(j)  (256  + 64 * (j))
#define XB_XSUB(j)  (1280 + 64 * (j))
#define XB_XGEN(j)  (2304 + 64 * (j))
#define XB_TOP      3328
#define XB_TOPGEN   3392
#define XCD_BAR_WORDS 3456
#define XB_SPIN_CAP (1u << 22)
__device__ __forceinline__ unsigned xb_ld(unsigned* p)              { return __hip_atomic_load(p, __ATOMIC_RELAXED, __HIP_MEMORY_SCOPE_AGENT); }
__device__ __forceinline__ unsigned xb_add(unsigned* p, unsigned v) { return __hip_atomic_fetch_add(p, v, __ATOMIC_RELAXED, __HIP_MEMORY_SCOPE_AGENT); }
__device__ __forceinline__ unsigned xb_xcc_id() { return (unsigned)__builtin_amdgcn_s_getreg((3 << 11) | 20) & 0xFu; }
#define XB_SPIN(cond, bar) do { unsigned _sp = 0; while (cond) { __builtin_amdgcn_s_sleep(1); \
    if ((++_sp & 255u) == 0u) { if (xb_ld(&(bar)[XB_TMO])) break; if (_sp > XB_SPIN_CAP) { atomicAdd(&(bar)[XB_TMO], 1u); break; } } } } while (0)
__device__ __forceinline__ void xcd_barrier_complete(unsigned* bar, unsigned x, unsigned& nloc, unsigned& nx) {
    const unsigned G = gridDim.x * gridDim.y * gridDim.z;
    unsigned sum, cnt, mine, sp = 0u;
    for (;;) {
        sum = 0u; cnt = 0u; mine = 0u;
#pragma unroll
        for (unsigned j = 0; j < 16; ++j) { const unsigned c = xb_ld(&bar[XB_XCNT(j)]); sum += c; cnt += (c > 0u) ? 1u : 0u; mine = (j == x) ? c : mine; }
        if (sum == G) break;
        __builtin_amdgcn_s_sleep(1);
        if ((++sp & 255u) == 0u) { if (xb_ld(&bar[XB_TMO])) break; if (sp > XB_SPIN_CAP) { atomicAdd(&bar[XB_TMO], 1u); break; } }
    }
    nloc = mine > 0u ? mine : 1u; nx = cnt > 0u ? cnt : 1u;
}
__device__ __forceinline__ void xcd_barrier(unsigned* bar, volatile __attribute__((address_space(3))) unsigned* st) {
    asm volatile("s_waitcnt vmcnt(0)" ::: "memory");
    __syncthreads();
    if (threadIdx.x == 0) {
        const unsigned x = xb_xcc_id();
        __builtin_amdgcn_s_waitcnt(0);
        unsigned nloc = st[0], nx = st[1];
        if (nloc == 0u) { xcd_barrier_complete(bar, x, nloc, nx); st[0] = nloc; st[1] = nx; }
        const unsigned old = xb_add(&bar[XB_XSUB(x)], 1u);
        const unsigned gen = old / nloc;
        if (old + 1u == (gen + 1u) * nloc) {
            __builtin_amdgcn_fence(__ATOMIC_RELEASE, "agent");
            asm volatile("s_waitcnt vmcnt(0)" ::: "memory");
            const unsigned og = xb_add(&bar[XB_TOP], 1u);
            const unsigned tg = og / nx;
            if (og + 1u == (tg + 1u) * nx) xb_add(&bar[XB_TOPGEN], 1u);
            else XB_SPIN(xb_ld(&bar[XB_TOPGEN]) == tg, bar);
            __builtin_amdgcn_fence(__ATOMIC_ACQUIRE, "agent");
            xb_add(&bar[XB_XGEN(x)], 1u);
            asm volatile("s_waitcnt vmcnt(0)" ::: "memory");
        } else {
            XB_SPIN(xb_ld(&bar[XB_XGEN(x)]) == gen, bar);
            __builtin_amdgcn_fence(__ATOMIC_ACQUIRE, "agent");
            asm volatile("s_waitcnt vmcnt(0)" ::: "memory");
        }
    }
    __syncthreads();
}

__device__ __forceinline__ const __attribute__((address_space(4))) Args* kargs() { unsigned long long p = (unsigned long long)__builtin_amdgcn_kernarg_segment_ptr(); asm volatile("" : "+s"(p)); return (const __attribute__((address_space(4))) Args*)p; }
__global__ void __launch_bounds__(512, 2) fox_fwd(Args args) {
    extern __shared__ __attribute__((aligned(16))) unsigned char lds[];
    cg::grid_group grid = cg::this_grid();
    const int G = gridDim.x, bx = blockIdx.x;
    constexpr int LDS_BARST = 131072 + 512;
    if (threadIdx.x < 64) ((LAS unsigned*)((PG8_LAS unsigned char*)lds + 131072))[threadIdx.x] = 0u;
    if (threadIdx.x < 2) ((LAS unsigned*)((PG8_LAS unsigned char*)lds + LDS_BARST))[threadIdx.x] = 0u;
    __syncthreads();
    if (threadIdx.x == 0 && args.ph_hi - args.ph_lo > 1) { unsigned* bar_ = (unsigned*)args.ws; (void)xb_add(&bar_[XB_XCNT(xb_xcc_id())], 1u); }
#define TIDS int tid = threadIdx.x; asm volatile("" : "+v"(tid)); const int lane = tid & 63, wave = __builtin_amdgcn_readfirstlane(tid >> 6); (void)lane; (void)wave;
#define PTRS \
    const __attribute__((address_space(4))) Args* A_ = kargs(); unsigned char* ws = A_->ws; float* out = A_->out; (void)ws; (void)out; \
    const float* x_prompt = A_->in[0]; const float* x_sample = A_->in[1]; (void)x_prompt; (void)x_sample; \
    float* rowss1 = (float*)(ws + WS_ROWSS); float* rowss2 = rowss1 + 65536; float* rowss3 = rowss2 + 65536; (void)rowss1; (void)rowss2; (void)rowss3; \
    bf16_t* Wgu1 = (bf16_t*)(ws + WS_WGU1); bf16_t* Wd1 = (bf16_t*)(ws + WS_WD1); bf16_t* Win = (bf16_t*)(ws + WS_WIN); bf16_t* Wo = (bf16_t*)(ws + WS_WO); \
    bf16_t* Wgu2 = (bf16_t*)(ws + WS_WGU2); bf16_t* Wd2 = (bf16_t*)(ws + WS_WD2); bf16_t* Wpool = (bf16_t*)(ws + WS_WPOOL); \
    bf16_t* ABUF = (bf16_t*)(ws + WS_ABUF); bf16_t* HB = (bf16_t*)(ws + WS_H); \
    bf16_t* Qb = (bf16_t*)(ws + WS_Q); bf16_t* Kb = (bf16_t*)(ws + WS_K); bf16_t* Vb = (bf16_t*)(ws + WS_V); float* Pb = (float*)(ws + WS_P); \
    bf16_t* Db = (bf16_t*)(ws + WS_D); bf16_t* MIX = (bf16_t*)(ws + WS_MIX); float* Cp = (float*)(ws + WS_C); float* SPL = (float*)(ws + WS_SPLIT); unsigned* SPC = (unsigned*)(ws + WS_SPLITCNT); (void)SPL; (void)SPC; \
    (void)Wgu1; (void)Wd1; (void)Win; (void)Wo; (void)Wgu2; (void)Wd2; (void)Wpool; (void)ABUF; (void)HB; (void)Qb; (void)Kb; (void)Vb; (void)Pb; (void)Db; (void)MIX; (void)Cp;
    PG8_LAS unsigned char* lds3 = (PG8_LAS unsigned char*)lds;
    const int lo = args.ph_lo, hi_ph = args.ph_hi;
#ifndef PH_MASK
#define PH_MASK 0x3ff
#endif
#define IN(k) (((PH_MASK >> (k)) & 1) && lo <= (k) && (k) < hi_ph)
#define SEAM(k) do { if (IN(k) && IN((k) + 1)) { unsigned* bar_ = (unsigned*)kargs()->ws; xcd_barrier(bar_, (volatile LAS unsigned*)((PG8_LAS unsigned char*)lds + LDS_BARST)); } } while (0)
    if (args.ph_hi - args.ph_lo > 1) grid.sync();

    if (IN(0)) { PTRS TIDS
        LAS float* scr = (LAS float*)(lds3 + wave * 16384);
        const int gw = bx * 8 + wave, NGW = G * 8;
        constexpr int I_GU = (DM / 64) * (DFF / 32), I_DN = (DFF / 64) * (DM / 32), I_INA = (DM / 64) * (3 * FOXW / 32), I_INP = (DM / 64) * (POOLW / 32), I_O = (DM / 64) * (DM / 32), I_PL = 4 * (256 / 64) * (256 / 32);
        constexpr int NITEMS = 4 * I_GU + 2 * I_DN + I_INA + I_INP + I_O + I_PL;
        for (int it = gw; it < NITEMS; it += NGW) {
            int r = it;
            if (r < 4 * I_GU) {
                const int which = r / I_GU; r -= which * I_GU; const int nblk = DFF / 32, kb = r / nblk, nb = r % nblk, n0 = 32 * nb;
                const float* W = A_->in[which == 0 ? 7 : which == 1 ? 8 : which == 2 ? 17 : 18];
                bf16_t* WT = which < 2 ? Wgu1 : Wgu2; const int drow = (n0 >> 7) * 256 + (which & 1) * 128 + (n0 & 127);
                transpose_item(W + n0, DFF, WT, DM, drow, 64 * kb, scr, lane, which < 2 ? A_->in[6] : A_->in[16]); continue; }
            r -= 4 * I_GU;
            if (r < 2 * I_DN) { const int which = r / I_DN; r -= which * I_DN; const int nblk = DM / 32, kb = r / nblk, nb = r % nblk;
                transpose_item(A_->in[which == 0 ? 9 : 19] + 32 * nb, DM, which == 0 ? Wd1 : Wd2, DFF, 32 * nb, 64 * kb, scr, lane); continue; }
            r -= 2 * I_DN;
            if (r < I_INA) { const int nblk = 3 * FOXW / 32, kb = r / nblk, nb = r % nblk; transpose_item(A_->in[11] + 32 * nb, INW, Win, DM, 32 * nb, 64 * kb, scr, lane, A_->in[10]); continue; }
            r -= I_INA;
            if (r < I_INP) { const int nblk = POOLW / 32, kb = r / nblk, nb = r % nblk; transpose_item(A_->in[11] + 3 * FOXW + NH + 32 * nb, INW, Win, DM, 3 * FOXW + 32 * nb, 64 * kb, scr, lane, A_->in[10]); continue; }
            r -= I_INP;
            if (r < I_O) { const int nblk = DM / 32, kb = r / nblk, nb = r % nblk;
                if (kb < 16) transpose_item(A_->in[15] + 32 * nb, DM, Wo, DM, 32 * nb, 64 * kb, scr, lane);
                else transpose_item(A_->in[15] + (size_t)FOXW * DM + 32 * nb, DM, (bf16_t*)(ws + WS_D), FOXW, 32 * nb, 64 * kb - FOXW, scr, lane);
                continue; }
            r -= I_O;
            { }
        }
        for (int i = bx * 512 + tid; i < NH * DM; i += G * 512) { const int j = i / DM, k = i % DM; Win[(size_t)(4 * FOXW + j) * DM + k] = (bf16_t)f2bf(A_->in[11][(size_t)k * INW + 3 * FOXW + j] * A_->in[10][k]); }
        for (int i = bx * 512 + tid; i < (INWP - 4 * FOXW - NH) * DM / 8; i += G * 512) *(u32x4*)(Win + (size_t)(4 * FOXW + NH) * DM + (size_t)i * 8) = (u32x4){0u, 0u, 0u, 0u};
        for (int i = bx * 512 + tid; i < 3 * 65536; i += G * 512) rowss1[i] = 0.f;
        for (int i = bx * 512 + tid; i < 4 * 65536; i += G * 512) Wpool[i] = (bf16_t)f2bf(A_->in[13][i] * A_->in[14][((i >> 16) << 8) + (i & 255)]);
        for (int i = bx * 512 + tid; i < MP * NH; i += G * 512) { ((float*)(ws + WS_NQ2))[i] = 0.f; ((float*)(ws + WS_NK2))[i] = 0.f; }
        float* rowss0 = rowss1 + 3 * 65536;
        for (int m = gw; m < MTOT; m += NGW) {
            const f32x4* xr = (const f32x4*)(m < MP ? x_prompt + (size_t)m * DM : x_sample + (size_t)(m - MP) * DM) + lane;
            f32x4 v[8]; float s = 0.f;
#pragma unroll
            for (int j = 0; j < 8; ++j) { v[j] = xr[64 * j]; s += (v[j][0] * v[j][0] + v[j][1] * v[j][1]) + (v[j][2] * v[j][2] + v[j][3] * v[j][3]); }
            const float st = wave_sum(s); if (lane == 0) rowss0[m] = st;
            u32x2* o8 = (u32x2*)(ABUF + (size_t)m * DM) + lane;
#pragma unroll
            for (int j = 0; j < 8; ++j) o8[64 * j] = (u32x2){cvt_pk_bf16(v[j][0], v[j][1]), cvt_pk_bf16(v[j][2], v[j][3])};
        }
    }
    SEAM(0);
    if (IN(1)) { PTRS TIDS pg8::Gemm g{ABUF, Wgu1, MTOT, 2 * DFF, DM, DM, 0}; pg8::StaticOrder S; S.init(MTOT, 2 * DFF, DM, G, bx, 0, nullptr, nullptr);
        pg8::EpiGU E{HB, rowss1 + 3 * 65536}; pg8::gemm_phase(lds3, g, S, E); }
    SEAM(1);
    if (IN(2)) { PTRS TIDS pg8::Gemm g{HB, Wd1, MTOT, DM, DFF, DFF, 0}; pg8::StaticOrder S; S.init(MTOT, DM, DFF, G, bx, 0, SPL, SPC);
        pg8::EpiRes E{nullptr, nullptr, ABUF, 0.5f, ABUF, rowss1};   pg8::gemm_phase(lds3, g, S, E); }
    SEAM(2);
    if (IN(3)) { PTRS TIDS pg8::Gemm g{ABUF, Win, MTOT, INWP, DM, DM, 0}; pg8::StaticOrder S; S.init(MTOT, INWP, DM, G, bx, 0, nullptr, nullptr);
        pg8::EpiIn E{rowss1, out, Qb, Kb, Vb, Pb, A_->in[12], (float*)(ws + WS_NQ2), (float*)(ws + WS_NK2)}; pg8::gemm_phase(lds3, g, S, E); }
    SEAM(3);
    if (IN(4)) { PTRS TIDS
        { pg8::Gemm g{(bf16_t*)(ws + WS_D), Wpool, DM, POOLW, 256, POOLW, 256}; pg8::StaticOrder S; S.init(DM, POOLW, 256, G, bx, 0, nullptr, nullptr);
          pg8::EpiFold E{Wo}; pg8::gemm_phase(lds3, g, S, E); __syncthreads(); }
        if (bx >= G - 32 && wave == 0) {
            const int bh = bx - (G - 32), b = bh >> 3, h = bh & 7; const float* lf = out + O_LFP + (size_t)b * SEQ * NH + h; float* c = Cp + (size_t)bh * SEQ; float carry = 0.f;
            const float* nq = (const float*)(ws + WS_NQ2) + (size_t)b * SEQ * NH + h; const float* nk = (const float*)(ws + WS_NK2) + (size_t)b * SEQ * NH + h;
            float* QN = (float*)(ws + WS_QN) + bh * 32; float* KN = (float*)(ws + WS_KN) + bh; float qmax = 0.f, kmax = 0.f;
            for (int ch = 0; ch < SEQ / 64; ++ch) { float v = lf[(size_t)(ch * 64 + lane) * NH];
                qmax = fmaxf(qmax, ld_agent(nq + (size_t)(ch * 64 + lane) * NH)); kmax = fmaxf(kmax, ld_agent(nk + (size_t)(ch * 64 + lane) * NH));
#pragma unroll
                for (int o = 1; o < 64; o <<= 1) { const float t = __shfl_up(v, o); if (lane >= o) v += t; }
                v += carry; carry = __shfl(v, 63); c[ch * 64 + lane] = v;
                if ((ch & 3) == 3) {
#pragma unroll
                    for (int o = 1; o < 64; o <<= 1) qmax = fmaxf(qmax, __shfl_xor(qmax, o));
                    if (lane == 0) QN[ch >> 2] = qmax; qmax = 0.f; } }
#pragma unroll
            for (int o = 1; o < 64; o <<= 1) kmax = fmaxf(kmax, __shfl_xor(kmax, o));
            if (lane == 0) *KN = kmax;
        }
        const float* sp = A_->in[5];
        for (int item = bx; item < MTOT / 64; item += G) {
            const int m0 = (item * 2 + (tid >> 8)) * 32, col = (tid & 255) * 4, w = 2 << (col >> 8);
            const bool samp = m0 >= MP; const int t0 = samp ? 0 : (m0 & (SEQ - 1)); const int sb = samp ? (m0 - MP) >> 5 : 0;
            const float* hist = sp + (size_t)sb * PHIST * POOLW + col;
            const float* P = Pb + (size_t)m0 * POOLW + col;
            f32x4 s = {0.f, 0.f, 0.f, 0.f};
            for (int j = 1; j < w; ++j) { f32x4 v = {0.f, 0.f, 0.f, 0.f};
                if (samp) v = *(const f32x4*)(hist + (size_t)(PHIST - j) * POOLW); else if (t0 - j >= 0) v = *(const f32x4*)(P - (size_t)j * POOLW);
                s += v; }
            for (int i0 = 0; i0 < 32; i0 += 8) {
                f32x4 curv[8], oldv[8];
#pragma unroll
                for (int e = 0; e < 8; ++e) { const int i = i0 + e, io = i - (w - 1); curv[e] = *(const f32x4*)(P + (size_t)i * POOLW); f32x4 old = {0.f, 0.f, 0.f, 0.f};
                    if (io >= 0) old = *(const f32x4*)(P + (size_t)io * POOLW);
                    else { const int j = -io; if (samp) old = *(const f32x4*)(hist + (size_t)(PHIST - j) * POOLW); else if (t0 - j >= 0) old = *(const f32x4*)(P - (size_t)j * POOLW); }
                    oldv[e] = old; }
#pragma unroll
                for (int e = 0; e < 8; ++e) { const int i = i0 + e; const f32x4 cur = curv[e]; s += cur;
                    const int cnt = samp ? w : ((t0 + i + 1) < w ? (t0 + i + 1) : w);
                    const f32x4 d = s * (1.0f / (float)cnt) - cur;
                    *(u32x2*)(MIX + (size_t)(m0 + i) * DM + FOXW + col) = (u32x2){cvt_pk_bf16(d[0], d[1]), cvt_pk_bf16(d[2], d[3])};
                    s -= oldv[e];
                    if (!samp) { const int t = t0 + i; if (t >= SEQ - PHIST) *(f32x4*)(out + O_PP + ((size_t)(m0 >> 13) * PHIST + (t - (SEQ - PHIST))) * POOLW + col) = cur; }
                    else if (i >= ST - PHIST) *(f32x4*)(out + O_PS + ((size_t)sb * PHIST + (i - (ST - PHIST))) * POOLW + col) = cur; }
            }
        }
    }
    SEAM(4);
    if (IN(5)) { PTRS TIDS
#ifndef P5_PARTS
#define P5_PARTS 7
#endif
        if (P5_PARTS & 1) {
            fox::Seam S; unsigned* qctr = (unsigned*)(ws + WS_QUEUE); const float* QN = (const float*)(ws + WS_QN); const float* KN = (const float*)(ws + WS_KN);
            int* nl = (int*)((char*)lds + fox::LDS_BIAS - 32);
            auto mkref = [&](int n) { const int bh = n & 31, qb = 31 - (n >> 5), b = bh >> 3, h = bh & 7;
                fox::BlockRef r; r.K = Kb + (size_t)bh * SEQ * HD; r.O = MIX + ((size_t)b * SEQ + (size_t)qb * 256) * DM + h * HD; r.C = Cp + (size_t)bh * SEQ; r.P0 = qb * 256;
                r.nrm = 1.02f * fox::SCALE * sqrtf(QN[bh * 32 + qb] * KN[bh]); return r; };
#define GRAB(dst) do { if (tid == 0) *nl = (int)__hip_atomic_fetch_add(qctr, 1u, __ATOMIC_RELAXED, __HIP_MEMORY_SCOPE_AGENT); __syncthreads(); dst = __builtin_amdgcn_readfirstlane(*nl); __syncthreads(); } while (0)
            int n; GRAB(n);
            if (n < NB * NH * 32) {
                fox::BlockRef cur = mkref(n);
                fox::prime(cur, (char*)lds, S);
                for (;;) {
                    int nn; GRAB(nn); const bool last = nn >= NB * NH * 32;
                    const fox::BlockRef nxt = last ? cur : mkref(nn);
                    fox::block(cur, nxt, (char*)lds, S);
                    if (last) break;
                    cur = nxt;
                }
            }
#undef GRAB
            asm volatile("s_waitcnt vmcnt(0)" ::: "memory"); __syncthreads();
        }
        if (P5_PARTS & 2) for (;;) { int* nl2 = (int*)((char*)lds + 65536); unsigned* sctr = (unsigned*)(ws + WS_QUEUE) + 16;
            __syncthreads(); if (tid == 0) *nl2 = (int)__hip_atomic_fetch_add(sctr, 1u, __ATOMIC_RELAXED, __HIP_MEMORY_SCOPE_AGENT); __syncthreads(); const int u = __builtin_amdgcn_readfirstlane(*nl2); __syncthreads(); if (u >= SBATCH * NH) break;
            const int b = u >> 3, h = u & 7;
            fox::sample_unit(b, h, A_->in[2], A_->in[3], A_->in[4], out + O_KS, out + O_VS, out + O_LFS, Qb + (size_t)MP * FOXW, MIX + (size_t)MP * DM, (char*)lds);
        }
        __syncthreads();
    }
    SEAM(5);
    if (IN(6)) { PTRS TIDS pg8::Gemm g{MIX, Wo, MTOT, DM, DM, DM, 0}; pg8::StaticOrder S; S.init(MTOT, DM, DM, G, bx, 16, SPL, SPC);
        pg8::EpiRes E{nullptr, nullptr, ABUF, 1.0f, ABUF, rowss2}; pg8::gemm_phase(lds3, g, S, E); }
    SEAM(6);
    if (IN(7)) { PTRS TIDS pg8::Gemm g{ABUF, Wgu2, MTOT, 2 * DFF, DM, DM, 0}; pg8::StaticOrder S; S.init(MTOT, 2 * DFF, DM, G, bx, 0, nullptr, nullptr);
        pg8::EpiGU E{HB, rowss2}; pg8::gemm_phase(lds3, g, S, E); }
    SEAM(7);
    if (IN(8)) { PTRS TIDS pg8::Gemm g{HB, Wd2, MTOT, DM, DFF, DFF, 0}; pg8::StaticOrder S; S.init(MTOT, DM, DFF, G, bx, 32, SPL, SPC);
        pg8::EpiRes E{nullptr, nullptr, ABUF, 0.5f, ABUF, rowss3};   pg8::gemm_phase(lds3, g, S, E); }
    SEAM(8);
    if (IN(9)) { PTRS TIDS
        const float* gf = A_->in[20]; const int gw = bx * 8 + wave, NGW = G * 8;
        for (int m = gw; m < MTOT; m += 2 * NGW) { const int m2 = m + NGW; const bool two = m2 < MTOT; const int mb = two ? m2 : m;
            const u32x2* pa = (const u32x2*)(ABUF + (size_t)m * DM) + lane; const u32x2* pb = (const u32x2*)(ABUF + (size_t)mb * DM) + lane;
            f32x4* ya = (f32x4*)(out + O_Y + (size_t)m * DM) + lane; f32x4* yb = (f32x4*)(out + O_Y + (size_t)mb * DM) + lane;
            const float ra = rstd_of(rowss3, m), rb = rstd_of(rowss3, mb);
            u32x2 va[8], vb[8];
#pragma unroll
            for (int j = 0; j < 8; ++j) { va[j] = pa[64 * j]; vb[j] = pb[64 * j]; }
#pragma unroll
            for (int j = 0; j < 8; ++j) { const f32x4 gg = ((const f32x4*)gf)[lane + 64 * j];
                const f32x4 xa = {__uint_as_float(va[j].x << 16), __uint_as_float(va[j].x & 0xffff0000u), __uint_as_float(va[j].y << 16), __uint_as_float(va[j].y & 0xffff0000u)};
                const f32x4 xb = {__uint_as_float(vb[j].x << 16), __uint_as_float(vb[j].x & 0xffff0000u), __uint_as_float(vb[j].y << 16), __uint_as_float(vb[j].y & 0xffff0000u)};
                ya[64 * j] = xa * ra * gg; if (two) yb[64 * j] = xb * rb * gg; } }
    }
#undef IN
#undef SEAM
}

#ifndef MK_SPLIT
#define MK_SPLIT 0
#endif
extern "C" void kernel_launch(void* const* d_in, const int* in_sizes, int n_in, void* d_out, int out_size, void* d_ws, size_t ws_size, hipStream_t stream) {
    static int grid = 0;
    if (grid == 0) {
        if (n_in != 21 || (size_t)out_size != O_END || ws_size < WS_END) { fprintf(stderr, "kernel_launch: unexpected shapes (n_in %d out %d ws %zu)\n", n_in, out_size, ws_size); grid = -1; return; }
        int dev = 0, cus = 0, per_cu = 0;
        (void)hipGetDevice(&dev); (void)hipDeviceGetAttribute(&cus, hipDeviceAttributeMultiprocessorCount, dev);
        if (hipFuncSetAttribute((const void*)fox_fwd, hipFuncAttributeMaxDynamicSharedMemorySize, LDS_BYTES) != hipSuccess) { fprintf(stderr, "hipFuncSetAttribute failed\n"); grid = -1; return; }
        if (hipOccupancyMaxActiveBlocksPerMultiprocessor(&per_cu, (const void*)fox_fwd, 512, LDS_BYTES) != hipSuccess || per_cu < 1) per_cu = 1;
        (void)hipGetLastError();
        grid = cus * per_cu;
        fprintf(stderr, "fox_fwd: cus %d per_cu %d grid %d\n", cus, per_cu, grid);
    }
    if (grid < 0) return;
    if (hipMemsetAsync(d_ws, 0, 65536, stream) != hipSuccess) { fprintf(stderr, "memset failed\n"); return; }
    Args a{};
    for (int i = 0; i < 21; ++i) a.in[i] = (const float*)d_in[i];
    a.out = (float*)d_out; a.ws = (unsigned char*)d_ws;
#if MK_SPLIT
    for (int p = 0; p < 10; ++p) { a.ph_lo = p; a.ph_hi = p + 1; hipLaunchKernelGGL(fox_fwd, dim3(grid), dim3(512), LDS_BYTES, stream, a); }
#else
    a.ph_lo = 0; a.ph_hi = 10;
    void* kargs[] = {&a};
    hipError_t e = hipLaunchCooperativeKernel((const void*)fox_fwd, dim3(grid), dim3(512), kargs, LDS_BYTES, stream);
    if (e != hipSuccess) fprintf(stderr, "cooperative launch failed: %s (grid %d)\n", hipGetErrorString(e), grid);
#endif
}
```
